# Optimizing an MI355X kernel written in HIP

```python
import math
import jax, jax.numpy as jnp
from jax import lax
import numpy as np

D_MODEL = 4096
BATCH = 16
SEQ = 256
DEPTH = 2
DEC_BATCH = 4
DEC_SEQ = 2048
PAST_LEN = 256

GRID_W = 64
HEAD_DIM = 128
D_MIX = D_MODEL
GROUP_W = D_MIX // 4
A_HEADS = GROUP_W // HEAD_DIM
A_KH = 8
A_KW = 16
B_HEADS = GROUP_W // HEAD_DIM
B_NOPE = 128
B_ROPE = 64
B_V = 128
B_Q_LORA = 3 * D_MODEL // 16
B_KV_LORA = 512
C_HEADS = GROUP_W // HEAD_DIM
C_KV_HEADS = 2
D_HEADS = GROUP_W // HEAD_DIM
D_QK = HEAD_DIM // 2
D_V = HEAD_DIM
ROPE_THETA = 10000.0
Q_BLOCK = 128
EPS = 1e-6
IN_SIZES = (A_HEADS * HEAD_DIM, A_HEADS * HEAD_DIM, A_HEADS * HEAD_DIM, GROUP_W,
            B_Q_LORA, B_KV_LORA, B_ROPE, GROUP_W,
            C_HEADS * HEAD_DIM, C_KV_HEADS * HEAD_DIM, C_KV_HEADS * HEAD_DIM, GROUP_W,
            D_HEADS * 2 * D_QK, D_HEADS * 2 * D_QK, D_HEADS * D_V, GROUP_W)
IN_COLS = sum(IN_SIZES)

kernel_name = 'hybrid_headgroup_diffusion_step'


def rmsnorm(x, g):
    xf = x.astype(jnp.float32)
    y = xf * lax.rsqrt(jnp.mean(xf * xf, axis=-1, keepdims=True) + EPS)
    return (y * g.astype(jnp.float32)).astype(x.dtype)


def rope_1d(x, pos):
    d = x.shape[-1]
    half = d // 2
    freqs = ROPE_THETA ** (-(jnp.arange(half, dtype=jnp.float32) * 2.0 / d))
    ang = pos.astype(jnp.float32)[:, None] * freqs[None, :]
    shape = (1, x.shape[1]) + (1,) * (x.ndim - 3) + (half,)
    cos = jnp.cos(ang).reshape(shape)
    sin = jnp.sin(ang).reshape(shape)
    xf = x.astype(jnp.float32)
    x1, x2 = xf[..., :half], xf[..., half:]
    return jnp.concatenate([x1 * cos - x2 * sin, x2 * cos + x1 * sin], axis=-1).astype(x.dtype)


def axial_rope(x):
    t = jnp.arange(x.shape[1])
    h = x.shape[-1] // 2
    return jnp.concatenate([rope_1d(x[..., :h], t // GRID_W), rope_1d(x[..., h:], t % GRID_W)], axis=-1)


def block_attn(q, k, v, scale):
    B, T, G, R, Dk = q.shape
    nb = T // Q_BLOCK
    qb = jnp.moveaxis(q.reshape(B, nb, Q_BLOCK, G, R, Dk), 1, 0)

    def one(qi):
        s = jnp.einsum('bqgrd,bsgd->bgrqs', qi, k, preferred_element_type=jnp.float32) * scale
        p = jax.nn.softmax(s, axis=-1)
        return jnp.einsum('bgrqs,bsge->bqgre', p.astype(v.dtype), v)

    o = lax.map(one, qb)
    return jnp.moveaxis(o, 0, 1).reshape(B, T, G, R, v.shape[-1])


def natten_attn(q, k, v, k_ctx, v_ctx, rpb):
    B, T, H, Dh = q.shape
    rows = T // GRID_W
    kh = min(A_KH, rows)
    r = jnp.arange(rows)
    start_r = jnp.clip(r - kh // 2, 0, rows - kh)
    row_idx = start_r[:, None] + jnp.arange(kh)[None, :]
    col = jnp.arange(GRID_W)
    start_c = jnp.clip(col - A_KW // 2, 0, GRID_W - A_KW)
    col_ok = (col[None, :] >= start_c[:, None]) & (col[None, :] < start_c[:, None] + A_KW)
    dr_idx = row_idx - r[:, None] + (A_KH - 1)
    dc_idx = jnp.clip(col[None, :] - col[:, None], -(A_KW - 1), A_KW - 1) + (A_KW - 1)
    bias = rpb.astype(jnp.float32)[:, dr_idx[:, None, :, None], dc_idx[None, :, None, :]]
    scale = Dh ** -0.5
    qg = q.reshape(B, rows, GRID_W, H, Dh)
    kg = k.reshape(B, rows, GRID_W, H, Dh)[:, row_idx]
    vg = v.reshape(B, rows, GRID_W, H, Dh)[:, row_idx]
    s_loc = jnp.einsum('brqhd,brkwhd->bhrqkw', qg, kg, preferred_element_type=jnp.float32) * scale
    s_loc = jnp.where(col_ok[None, None, None, :, None, :], s_loc + bias[None], -jnp.inf)
    s_ctx = jnp.einsum('brqhd,bshd->bhrqs', qg, k_ctx, preferred_element_type=jnp.float32) * scale
    nloc = kh * GRID_W
    s = jnp.concatenate([s_loc.reshape(B, H, rows, GRID_W, nloc), s_ctx], axis=-1)
    p = jax.nn.softmax(s, axis=-1).astype(v.dtype)
    p_loc = p[..., :nloc].reshape(B, H, rows, GRID_W, kh, GRID_W)
    p_ctx = p[..., nloc:]
    o = jnp.einsum('bhrqkw,brkwhd->brqhd', p_loc, vg) + jnp.einsum('bhrqs,bshd->brqhd', p_ctx, v_ctx)
    return o.reshape(B, T, H * Dh)


def mla_expand(ckv, kpe, w_ukv):
    B, S, _ = ckv.shape
    kv = jnp.einsum('bsc,ce->bse', ckv, w_ukv).reshape(B, S, B_HEADS, B_NOPE + B_V)
    k_nope, v = kv[..., :B_NOPE], kv[..., B_NOPE:]
    k_pe = jnp.broadcast_to(kpe[:, :, None, :], (B, S, B_HEADS, B_ROPE))
    return jnp.concatenate([k_nope, k_pe], axis=-1), v


def mla_attn(q, k, v):
    B, T = q.shape[:2]
    return block_attn(q[:, :, :, None], k, v, (B_NOPE + B_ROPE) ** -0.5).reshape(B, T, B_HEADS * B_V)


def gqa_attn(q, k, v):
    B, T = q.shape[:2]
    qg = q.reshape(B, T, C_KV_HEADS, C_HEADS // C_KV_HEADS, HEAD_DIM)
    return block_attn(qg, k, v, HEAD_DIM ** -0.5).reshape(B, T, C_HEADS * HEAD_DIM)


def diff_attn(q, k, v, lp, lam_init):
    B, T = q.shape[:2]
    S = k.shape[1]
    o = block_attn(q.reshape(B, T, D_HEADS * 2, 1, D_QK), k.reshape(B, S, D_HEADS * 2, D_QK),
                   jnp.repeat(v, 2, axis=2), D_QK ** -0.5)
    o = o.reshape(B, T, D_HEADS, 2, D_V).astype(jnp.float32)
    f32 = jnp.float32
    lam = (jnp.exp(jnp.sum(lp['d_lq1'].astype(f32) * lp['d_lk1'].astype(f32)))
           - jnp.exp(jnp.sum(lp['d_lq2'].astype(f32) * lp['d_lk2'].astype(f32))) + lam_init)
    od = o[..., 0, :] - lam * o[..., 1, :]
    od = rmsnorm(od, lp['d_subln']) * (1.0 - lam_init)
    return od.reshape(B, T, D_HEADS * D_V).astype(q.dtype)


def project(h, lp):
    B, T, _ = h.shape
    z = jnp.einsum('btd,de->bte', h, lp['w_in'])
    offsets = np.cumsum(IN_SIZES)[:-1].tolist()
    (a_q, a_k, a_v, a_z, b_cq, b_ckv, b_kpe, b_z,
     c_q, c_k, c_v, c_z, d_q, d_k, d_v, d_z) = jnp.split(z, offsets, axis=-1)
    b_q = jnp.einsum('btc,ce->bte', rmsnorm(b_cq, lp['b_q_norm']), lp['b_w_uq'])
    qs = (a_q.reshape(B, T, A_HEADS, HEAD_DIM),
          b_q.reshape(B, T, B_HEADS, B_NOPE + B_ROPE),
          rmsnorm(c_q.reshape(B, T, C_HEADS, HEAD_DIM), lp['c_q_norm']),
          d_q.reshape(B, T, D_HEADS, 2, D_QK))
    kvs = (a_k.reshape(B, T, A_HEADS, HEAD_DIM), a_v.reshape(B, T, A_HEADS, HEAD_DIM),
           rmsnorm(b_ckv, lp['b_kv_norm']), b_kpe,
           rmsnorm(c_k.reshape(B, T, C_KV_HEADS, HEAD_DIM), lp['c_k_norm']),
           c_v.reshape(B, T, C_KV_HEADS, HEAD_DIM),
           d_k.reshape(B, T, D_HEADS, 2, D_QK), d_v.reshape(B, T, D_HEADS, D_V))
    gates = (a_z, b_z, c_z, d_z)
    return qs, kvs, gates


def merge(outs, gates, w_out):
    y = jnp.concatenate([o * jax.nn.silu(z) for o, z in zip(outs, gates)], axis=-1)
    return jnp.einsum('bte,ed->btd', y, w_out)


def mix_context(h, lp, lam_init):
    B, T = h.shape[:2]
    qs, kvs, gates = project(h, lp)
    q_a, q_b, q_c, q_d = qs
    a_k, a_v, b_ckv, b_kpe, c_k, c_v, d_k, d_v = kvs
    o_a = block_attn(q_a[:, :, :, None], a_k, a_v, HEAD_DIM ** -0.5).reshape(B, T, A_HEADS * HEAD_DIM)
    k_b, v_b = mla_expand(b_ckv, b_kpe, lp['b_w_ukv'])
    o_b = mla_attn(q_b, k_b, v_b)
    o_c = gqa_attn(q_c, c_k, c_v)
    o_d = diff_attn(q_d, d_k, d_v, lp, lam_init)
    return merge((o_a, o_b, o_c, o_d), gates, lp['w_out']), kvs


def mix_latent(h, lp, ctx, lam_init):
    qs, kvs, gates = project(h, lp)
    q_a, q_b, q_c, q_d = qs
    a_k, a_v, b_ckv, b_kpe, c_k, c_v, d_k, d_v = kvs
    ca_k, ca_v, cb_ckv, cb_kpe, cc_k, cc_v, cd_k, cd_v = ctx
    o_a = natten_attn(q_a, a_k, a_v, ca_k, ca_v, lp['a_rpb'])
    q_b = jnp.concatenate([q_b[..., :B_NOPE], axial_rope(q_b[..., B_NOPE:])], axis=-1)
    k_bl, v_bl = mla_expand(b_ckv, axial_rope(b_kpe), lp['b_w_ukv'])
    k_bc, v_bc = mla_expand(cb_ckv, cb_kpe, lp['b_w_ukv'])
    o_b = mla_attn(q_b, jnp.concatenate([k_bl, k_bc], axis=1), jnp.concatenate([v_bl, v_bc], axis=1))
    o_c = gqa_attn(axial_rope(q_c), jnp.concatenate([axial_rope(c_k), cc_k], axis=1),
                   jnp.concatenate([c_v, cc_v], axis=1))
    o_d = diff_attn(axial_rope(q_d), jnp.concatenate([axial_rope(d_k), cd_k], axis=1),
                    jnp.concatenate([d_v, cd_v], axis=1), lp, lam_init)
    return merge((o_a, o_b, o_c, o_d), gates, lp['w_out'])


def modulate(x, g, mod):
    shift, scale, gate = jnp.split(mod, 3, axis=-1)
    return rmsnorm(x, g) * (1.0 + scale) + shift, gate


def setup_inputs(seed: int = 0) -> dict:
    key = jax.random.key(seed)
    ks = jax.random.split(key, 32)
    f32 = jnp.float32

    def nrm(k, shape, s=1.0):
        return jax.random.normal(k, shape, f32) * s

    def gain(k, shape):
        return 1.0 + 0.02 * jax.random.normal(k, shape, f32)

    return {
        'x_prompt': nrm(ks[0], (BATCH, SEQ, D_MODEL)),
        'x_sample': nrm(ks[1], (DEC_BATCH, DEC_SEQ, D_MODEL)),
        'cache_a_k': nrm(ks[2], (DEC_BATCH, DEPTH, PAST_LEN, A_HEADS, HEAD_DIM)),
        'cache_a_v': nrm(ks[3], (DEC_BATCH, DEPTH, PAST_LEN, A_HEADS, HEAD_DIM)),
        'cache_b_ckv': nrm(ks[4], (DEC_BATCH, DEPTH, PAST_LEN, B_KV_LORA)),
        'cache_b_kpe': nrm(ks[5], (DEC_BATCH, DEPTH, PAST_LEN, B_ROPE)),
        'cache_c_k': nrm(ks[6], (DEC_BATCH, DEPTH, PAST_LEN, C_KV_HEADS, HEAD_DIM)),
        'cache_c_v': nrm(ks[7], (DEC_BATCH, DEPTH, PAST_LEN, C_KV_HEADS, HEAD_DIM)),
        'cache_d_k': nrm(ks[8], (DEC_BATCH, DEPTH, PAST_LEN, D_HEADS, 2, D_QK)),
        'cache_d_v': nrm(ks[9], (DEC_BATCH, DEPTH, PAST_LEN, D_HEADS, D_V)),
        'c': nrm(ks[10], (DEC_BATCH, D_MODEL)),
        'c_ctx': nrm(ks[11], (D_MODEL,)),
        'norm_g': gain(ks[12], (DEPTH, D_MODEL)),
        'w_ada': nrm(ks[13], (DEPTH, D_MODEL, 3 * D_MODEL), 0.5 * D_MODEL ** -0.5),
        'b_ada': nrm(ks[14], (DEPTH, 3 * D_MODEL), 0.02),
        'w_in': nrm(ks[15], (DEPTH, D_MODEL, IN_COLS), D_MODEL ** -0.5),
        'w_out': nrm(ks[16], (DEPTH, D_MIX, D_MODEL), D_MIX ** -0.5),
        'a_rpb': nrm(ks[17], (DEPTH, A_HEADS, 2 * A_KH - 1, 2 * A_KW - 1), 0.1),
        'b_q_norm': gain(ks[18], (DEPTH, B_Q_LORA)),
        'b_w_uq': nrm(ks[19], (DEPTH, B_Q_LORA, B_HEADS * (B_NOPE + B_ROPE)), B_Q_LORA ** -0.5),
        'b_kv_norm': gain(ks[20], (DEPTH, B_KV_LORA)),
        'b_w_ukv': nrm(ks[21], (DEPTH, B_KV_LORA, B_HEADS * (B_NOPE + B_V)), B_KV_LORA ** -0.5),
        'c_q_norm': gain(ks[22], (DEPTH, HEAD_DIM)),
        'c_k_norm': gain(ks[23], (DEPTH, HEAD_DIM)),
        'd_lq1': nrm(ks[24], (DEPTH, D_QK), 0.1),
        'd_lk1': nrm(ks[25], (DEPTH, D_QK), 0.1),
        'd_lq2': nrm(ks[26], (DEPTH, D_QK), 0.1),
        'd_lk2': nrm(ks[27], (DEPTH, D_QK), 0.1),
        'd_subln': gain(ks[28], (DEPTH, D_V)),
        'final_norm_g': gain(ks[29], (D_MODEL,)),
    }


def reference(x_prompt, x_sample, cache_a_k, cache_a_v, cache_b_ckv, cache_b_kpe, cache_c_k, cache_c_v,
              cache_d_k, cache_d_v, c, c_ctx, norm_g, w_ada, b_ada, w_in, w_out, a_rpb, b_q_norm, b_w_uq,
              b_kv_norm, b_w_ukv, c_q_norm, c_k_norm, d_lq1, d_lk1, d_lq2, d_lk2, d_subln, final_norm_g):
    def layer_params(l):
        return dict(w_in=w_in[l], w_out=w_out[l], a_rpb=a_rpb[l], b_q_norm=b_q_norm[l], b_w_uq=b_w_uq[l],
                    b_kv_norm=b_kv_norm[l], b_w_ukv=b_w_ukv[l], c_q_norm=c_q_norm[l], c_k_norm=c_k_norm[l],
                    d_lq1=d_lq1[l], d_lk1=d_lk1[l], d_lq2=d_lq2[l], d_lk2=d_lk2[l], d_subln=d_subln[l])

    xp = x_prompt
    ctx_tensors = []
    silu_ctx = jax.nn.silu(c_ctx)
    for l in range(DEPTH):
        lp = layer_params(l)
        lam_init = 0.8 - 0.6 * math.exp(-0.3 * l)
        mod = jnp.einsum('d,de->e', silu_ctx, w_ada[l]) + b_ada[l]
        h, gate = modulate(xp, norm_g[l], mod)
        out, kvs = mix_context(h, lp, lam_init)
        xp = xp + gate * out
        ctx_tensors.append(kvs)
    y_prompt = rmsnorm(xp, final_norm_g)

    def stack_state(i):
        return jnp.stack([t[i] for t in ctx_tensors], axis=1)

    new_a_k = stack_state(0)
    new_a_v = stack_state(1)
    new_b_ckv = stack_state(2)
    new_b_kpe = stack_state(3)
    new_c_k = stack_state(4)
    new_c_v = stack_state(5)
    new_d_k = stack_state(6)
    new_d_v = stack_state(7)

    xs = x_sample
    silu_c = jax.nn.silu(c)
    for l in range(DEPTH):
        lp = layer_params(l)
        lam_init = 0.8 - 0.6 * math.exp(-0.3 * l)
        mod = (jnp.einsum('bd,de->be', silu_c, w_ada[l]) + b_ada[l])[:, None, :]
        h, gate = modulate(xs, norm_g[l], mod)
        ctx = (cache_a_k[:, l], cache_a_v[:, l], cache_b_ckv[:, l], cache_b_kpe[:, l],
               cache_c_k[:, l], cache_c_v[:, l], cache_d_k[:, l], cache_d_v[:, l])
        xs = xs + gate * mix_latent(h, lp, ctx, lam_init)
    y_sample = rmsnorm(xs, final_norm_g)

    return (y_prompt, y_sample, new_a_k, new_a_v, new_b_ckv, new_b_kpe, new_c_k, new_c_v, new_d_k, new_d_v)
```

```cpp
#include <hip/hip_runtime.h>
#include <cstdio>
#include <cstdint>

#ifndef MK_MODE
#define MK_MODE 0
#endif
#ifndef NAIVE_ATTN
#define NAIVE_ATTN 0
#endif

#define LAS __attribute__((address_space(3)))
typedef unsigned short bf16_t;
typedef short bf16x8 __attribute__((ext_vector_type(8)));
typedef short s16x4 __attribute__((ext_vector_type(4)));
typedef float f32x4 __attribute__((ext_vector_type(4)));
typedef float f32x2 __attribute__((ext_vector_type(2)));
typedef float f32x16 __attribute__((ext_vector_type(16)));
typedef unsigned u32x4 __attribute__((ext_vector_type(4)));
typedef unsigned u32x2 __attribute__((ext_vector_type(2)));

constexpr int DM = 4096, NPB = 16, PSEQ = 256, NLB = 4, LSEQ = 2048, PAST = 256, DEPTH = 2;
constexpr int NP = NPB * PSEQ, NL = NLB * LSEQ, NTOK = NP + NL;
constexpr int LKV = LSEQ + PAST, NKV = NP + NLB * LKV;
constexpr int INC = 13120, LDZ = 13312;
constexpr float EPS = 1e-6f;
constexpr int ZC_AQ = 0, ZC_AK = 1024, ZC_AV = 2048, ZC_AZ = 3072, ZC_BCQ = 4096, ZC_BCKV = 4864, ZC_BZ = 5376, ZC_CQ = 6400, ZC_CK = 7424, ZC_CV = 7680,
              ZC_CZ = 7936, ZC_DQ = 8960, ZC_DK = 9984, ZC_DV = 11008, ZC_DZ = 12032, ZC_BKPE = 13056;
constexpr int LDQB = 1536, LDKVB = 2048, LDO = 5120;
constexpr size_t O_YP = 0, O_YS = 16777216, O_AK = 50331648, O_AV = 58720256, O_BCKV = 67108864, O_BKPE = 71303168, O_CK = 71827456, O_CV = 73924608,
                 O_DK = 76021760, O_DV = 84410368, O_END = 92798976;
constexpr size_t MiB = 1u << 20;
constexpr size_t WS_CTL = 0, CTL_BYTES = 1 * MiB;
constexpr int CW_BAR = 4096;
constexpr int CW_Q = 8192;
constexpr size_t CTL_MOD = 65536;
constexpr size_t WS_TAB = 1 * MiB;
constexpr size_t WS_BT1 = 2 * MiB, BT1_L = (size_t)LDZ * DM * 2;
constexpr size_t WS_BT2 = WS_BT1 + 2 * BT1_L, BT2_L = (size_t)DM * DM * 2;
constexpr size_t WS_BUQ = WS_BT2 + 2 * BT2_L, BUQ_L = (size_t)1536 * 768 * 2;
constexpr size_t WS_BUKV = WS_BUQ + 2 * BUQ_L, BUKV_L = (size_t)2048 * 512 * 2;
constexpr size_t WS_H = WS_BUKV + 2 * BUKV_L;
constexpr size_t WS_Z = WS_H + (size_t)NTOK * DM * 2;
constexpr size_t WS_QB = WS_Z + (size_t)NKV * LDZ * 2;
constexpr size_t WS_KVB = WS_QB + (size_t)NKV * LDQB * 2;
constexpr size_t WS_OB = WS_KVB + (size_t)NKV * LDKVB * 2;
constexpr size_t WS_Y = WS_OB + (size_t)NTOK * LDO * 2;
constexpr size_t WS_X = WS_Y + (size_t)NTOK * DM * 2;
constexpr size_t WS_END = WS_X + (size_t)NTOK * DM * 4;
static_assert(WS_BT1 % 256 == 0 && WS_BT2 % 256 == 0 && WS_BUQ % 256 == 0 && WS_BUKV % 256 == 0 && WS_H % 256 == 0 && WS_Z % 256 == 0 && WS_QB % 256 == 0 && WS_KVB % 256 == 0 &&
              WS_OB % 256 == 0 && WS_Y % 256 == 0 && WS_X % 256 == 0, "ws alignment");
constexpr int TB_C64 = 0, TB_S64 = 1024, TB_C128 = 2048, TB_S128 = 4096, TB_LAM = 6144;
constexpr int RING_BYTES = 131072, MISC_OFF = RING_BYTES + 320, LDS_BYTES = 147456;
constexpr int NWAVES = 8, NTHR = 512;

#define LDS_WAIT() asm volatile("s_waitcnt lgkmcnt(0)" ::: "memory")
#define VM_WAIT() asm volatile("s_waitcnt vmcnt(0)" ::: "memory")
__device__ __forceinline__ unsigned f2bf(float f) { unsigned u = __builtin_bit_cast(unsigned, f); return (u + 0x7fffu + ((u >> 16) & 1u)) >> 16; }
__device__ __forceinline__ unsigned pk2(float lo, float hi) { return f2bf(lo) | (f2bf(hi) << 16); }
__device__ __forceinline__ float bf2f(unsigned short b) { return __builtin_bit_cast(float, ((unsigned)b) << 16); }
__device__ __forceinline__ float bflo(unsigned w) { return __builtin_bit_cast(float, w << 16); }
__device__ __forceinline__ float bfhi(unsigned w) { return __builtin_bit_cast(float, w & 0xffff0000u); }
__device__ __forceinline__ unsigned cvt_pk_bf16(float lo, float hi) { unsigned r; asm volatile("v_cvt_pk_bf16_f32 %0, %1, %2" : "=v"(r) : "v"(lo), "v"(hi)); return r; }
template <int M> __device__ __forceinline__ float shx(float x) {
    if constexpr (M < 32) return __builtin_bit_cast(float, __builtin_amdgcn_ds_swizzle(__builtin_bit_cast(int, x), (M << 10) | 0x1f));
    else { auto rr = __builtin_amdgcn_permlane32_swap(__builtin_bit_cast(unsigned, x), __builtin_bit_cast(unsigned, x), false, false);
           return __builtin_bit_cast(float, (unsigned)rr[0]) == x ? __builtin_bit_cast(float, (unsigned)rr[1]) : __builtin_bit_cast(float, (unsigned)rr[0]); }
}
__device__ __forceinline__ float wave_sum(float v) {
    v += shx<1>(v); v += shx<2>(v); v += shx<4>(v); v += shx<8>(v); v += shx<16>(v);
    auto rr = __builtin_amdgcn_permlane32_swap(__builtin_bit_cast(unsigned, v), __builtin_bit_cast(unsigned, v), false, false);
    return __builtin_bit_cast(float, (unsigned)rr[0]) + __builtin_bit_cast(float, (unsigned)rr[1]);
}
__device__ __forceinline__ float wave_max(float v) {
    v = fmaxf(v, shx<1>(v)); v = fmaxf(v, shx<2>(v)); v = fmaxf(v, shx<4>(v)); v = fmaxf(v, shx<8>(v)); v = fmaxf(v, shx<16>(v));
    auto rr = __builtin_amdgcn_permlane32_swap(__builtin_bit_cast(unsigned, v), __builtin_bit_cast(unsigned, v), false, false);
    return fmaxf(__builtin_bit_cast(float, (unsigned)rr[0]), __builtin_bit_cast(float, (unsigned)rr[1]));
}
__device__ __forceinline__ float silu_f(float x) { return x / (1.0f + __expf(-x)); }
__device__ __forceinline__ int kvrow_of_tok(int tok) { if (tok < NP) return tok; const int r = tok - NP; return NP + (r >> 11) * LKV + (r & 2047); }

namespace pg8 {
constexpr int BM = 256, BK = 64, HALF = 128, HTB = HALF * BK * 2, STAGE_BYTES = 8 * HTB, NXCD = 8, WGM = 8;
__host__ __device__ __forceinline__ int lds_byte(int r, int c) { const int st = (r >> 4) * 2 + (c >> 5), rr = r & 15, cc = c & 31, ob = rr * 64 + cc * 2; return st * 1024 + (ob ^ (((ob >> 9) & 1) << 5)); }
__host__ __device__ __forceinline__ void stage_rc(int b, int& R, int& C) { const int st = b / 1024, sb = b % 1024, swz = sb ^ (((sb >> 9) & 1) << 5); R = (st >> 1) * 16 + swz / 64; C = (st & 1) * 32 + (swz % 64) / 2; }
__host__ __device__ __forceinline__ int perm32(int rho) { const int n = rho >> 4, i = rho & 15; return 8 * (i >> 2) + 4 * n + (i & 3); }

struct Unit { int pm, pn; };
struct Gemm { const bf16_t* A; const bf16_t* Bt; int M, N, K, lda, ldb; };

struct StaticOrder {
    int nM, nN, nwg, G, c;
    __host__ __device__ void init(int M, int N, int G_, int c_) { nM = M / BM; nN = N / BM; nwg = nM * nN; G = G_; c = c_; }
    __host__ __device__ bool next(int i, Unit& u) const {
        const long L = (long)i * G + c; if (L >= nwg) return false;
        int wgid = (int)L; { const int q = nwg / NXCD, r = nwg % NXCD, xcd = wgid % NXCD, off = wgid / NXCD; wgid = (xcd < r ? xcd * (q + 1) : r * (q + 1) + (xcd - r) * q) + off; }
        const int nig = WGM * nN, gid = wgid / nig, fm = gid * WGM, gsz = (nM - fm) < WGM ? (nM - fm) : WGM;
        u.pm = fm + ((wgid % nig) % gsz); u.pn = (wgid % nig) / gsz; return true;
    }
    __device__ __forceinline__ void a_ready(const Unit&) const {}
    __device__ __forceinline__ void done(const Unit&) const {}
};

struct EpiBf16 {
    static constexpr bool PERM = true;
    bf16_t* O; int ldc; int remap;
    __device__ __forceinline__ void operator()(const f32x4 (&acc)[2][2][4][2], const Unit& u, int wr, int wc, int fr, int fq) const {
        int pmo = u.pm; if (remap && pmo >= 16) { const int j = pmo - 16; pmo = 16 + (j >> 3) * 9 + (j & 7); }
        const int row0 = pmo * BM + wr * 64 + fr, col0 = u.pn * BM + wc * 32 + 8 * fq;
#pragma unroll
        for (int ai = 0; ai < 2; ++ai)
#pragma unroll
            for (int m = 0; m < 4; ++m) { bf16_t* rowp = O + (size_t)(row0 + ai * HALF + m * 16) * ldc + col0;
#pragma unroll
                for (int bj = 0; bj < 2; ++bj) { const f32x4 v0 = acc[ai][bj][m][0], v1 = acc[ai][bj][m][1];
                    u32x4 w; w.x = cvt_pk_bf16(v0[0], v0[1]); w.y = cvt_pk_bf16(v0[2], v0[3]); w.z = cvt_pk_bf16(v1[0], v1[1]); w.w = cvt_pk_bf16(v1[2], v1[3]);
                    *(u32x4*)(rowp + bj * HALF) = w; } }
    }
};
struct EpiRes {
    static constexpr bool PERM = false;
    const float* xinP; const float* xinL; float* xout; const float* gate;
    __device__ __forceinline__ void operator()(const f32x4 (&acc)[2][2][4][2], const Unit& u, int wr, int wc, int fr, int fq) const {
        const int row0 = u.pm * BM + wr * 64 + fr, col0 = u.pn * BM + wc * 32 + 4 * fq;
        const int v = u.pm < 16 ? 0 : 1 + ((u.pm - 16) >> 3);
        const float* gv = gate + (size_t)v * 12288 + col0;
        const float* xb = u.pm < 16 ? xinP + (size_t)row0 * DM : xinL + (size_t)(row0 - NP) * DM;
        f32x4 g4[2][2];
#pragma unroll
        for (int bj = 0; bj < 2; ++bj)
#pragma unroll
            for (int n = 0; n < 2; ++n) g4[bj][n] = *(const f32x4*)(gv + bj * HALF + n * 16);
#pragma unroll
        for (int ai = 0; ai < 2; ++ai)
#pragma unroll
            for (int m = 0; m < 4; ++m) { const size_t ro = (size_t)(ai * HALF + m * 16) * DM + col0; float* op = xout + (size_t)row0 * DM + ro; const float* ip = xb + ro;
#pragma unroll
                for (int bj = 0; bj < 2; ++bj)
#pragma unroll
                    for (int n = 0; n < 2; ++n) { const f32x4 x4 = *(const f32x4*)(ip + bj * HALF + n * 16); *(f32x4*)(op + bj * HALF + n * 16) = x4 + g4[bj][n] * acc[ai][bj][m][n]; } }
    }
};

template <class Epi, class Sched>
__device__ __forceinline__ void gemm_phase(LAS unsigned char* lds, const Gemm g, const Sched& S, const Epi& E) {
    int tid_ = threadIdx.x; asm volatile("" : "+v"(tid_));
    const int tid = tid_, wid = __builtin_amdgcn_readfirstlane(tid >> 6), lane = tid & 63, wr = wid >> 2, wc = wid & 3, fr = lane & 15, fq = lane >> 4;
    const int K = g.K, nt = K / BK;
    unsigned voffA[2], voffB[2];
#pragma unroll
    for (int i = 0; i < 2; ++i) { int R, C; stage_rc(tid * 16 + i * 8192, R, C); const int Rb = Epi::PERM ? ((R & ~31) + perm32(R & 31)) : R;
        voffA[i] = (unsigned)(R * g.lda + C) * 2u; voffB[i] = (unsigned)(Rb * g.ldb + C) * 2u; }
    const size_t kstep = (size_t)(BK * 2);
    const size_t hstepA = (size_t)HALF * g.lda * 2, hstepB = (size_t)HALF * g.ldb * 2;
    const size_t tstepA = 2 * hstepA, tstepB = 2 * hstepB;
    const unsigned ldsw = (unsigned)wid * 1024u;
    const int aoff = lds_byte(wr * 64 + fr, fq * 8), boff = lds_byte(wc * 32 + fr, fq * 8);
#define PG8_SA(b, h) (((b) * 2 + (h)) * HTB)
#define PG8_SB(b, h) ((4 + (b) * 2 + (h)) * HTB)
#define PG8_STAGE(bufoff, gbase, voff) do { _Pragma("unroll") for (int _i = 0; _i < 2; ++_i) \
        __builtin_amdgcn_global_load_lds((const unsigned*)((const char*)(gbase) + (voff)[_i]), (LAS unsigned*)(lds + (bufoff) + ldsw + _i * 8192), 16, 0, 0); } while (0)
#define PG8_LDA(dst, b, h) do { _Pragma("unroll") for (int m = 0; m < 4; ++m) _Pragma("unroll") for (int k = 0; k < 2; ++k) dst[m][k] = *(const LAS bf16x8*)(lds + PG8_SA(b, h) + aoff + m * 2048 + k * 1024); } while (0)
#define PG8_LDB(dst, b, h) do { _Pragma("unroll") for (int n = 0; n < 2; ++n) _Pragma("unroll") for (int k = 0; k < 2; ++k) dst[n][k] = *(const LAS bf16x8*)(lds + PG8_SB(b, h) + boff + n * 2048 + k * 1024); } while (0)
#define PG8_MMA(ai, bj, At, Bt) do { __builtin_amdgcn_s_setprio(1); _Pragma("unroll") for (int m = 0; m < 4; ++m) _Pragma("unroll") for (int n = 0; n < 2; ++n) _Pragma("unroll") for (int k = 0; k < 2; ++k) \
        acc[ai][bj][m][n] = __builtin_amdgcn_mfma_f32_16x16x32_bf16(Bt[n][k], At[m][k], acc[ai][bj][m][n], 0, 0, 0); __builtin_amdgcn_s_setprio(0); } while (0)
#define PG8_WAIT_V(n) asm volatile("s_waitcnt vmcnt(" #n ")" ::: "memory")
#define PG8_WAIT_L(n) asm volatile("s_waitcnt lgkmcnt(" #n ")" ::: "memory")
#define PG8_BAR __builtin_amdgcn_s_barrier()
#define PG8_SCHED __builtin_amdgcn_sched_barrier(0)
    Unit cur, nxt; int ui = 0;
    if (!S.next(0, cur)) return;
    f32x4 acc[2][2][4][2];
#pragma unroll
    for (int a = 0; a < 2; ++a)
#pragma unroll
        for (int b = 0; b < 2; ++b)
#pragma unroll
            for (int m = 0; m < 4; ++m)
#pragma unroll
                for (int n = 0; n < 2; ++n) acc[a][b][m][n] = (f32x4){0.f, 0.f, 0.f, 0.f};
    bf16x8 At[4][2], B0[2][2], B1[2][2];
    const char* cA = (const char*)g.A + (size_t)cur.pm * tstepA; const char* cB = (const char*)g.Bt + (size_t)cur.pn * tstepB;
    S.a_ready(cur);
    PG8_STAGE(PG8_SB(0, 0), cB, voffB); PG8_STAGE(PG8_SA(0, 0), cA, voffA); PG8_STAGE(PG8_SB(0, 1), cB + hstepB, voffB); PG8_STAGE(PG8_SA(0, 1), cA + hstepA, voffA);
    if (wr == 1) PG8_BAR;
    PG8_WAIT_V(4); PG8_BAR;
    PG8_STAGE(PG8_SB(1, 0), cB + kstep, voffB); PG8_STAGE(PG8_SA(1, 0), cA + kstep, voffA); PG8_STAGE(PG8_SB(1, 1), cB + hstepB + kstep, voffB);
    PG8_WAIT_V(6); PG8_BAR;
    for (;;) {
        const bool has_next = S.next(ui + 1, nxt);
        const char* nA = has_next ? (const char*)g.A + (size_t)nxt.pm * tstepA : cA; const char* nB = has_next ? (const char*)g.Bt + (size_t)nxt.pn * tstepB : cB;
        for (int t = 0; t < nt; t += 2) {
            const bool last = (t == nt - 2);
            const char* a1 = cA + (size_t)(t + 1) * kstep;
            const char* a2 = last ? nA : cA + (size_t)(t + 2) * kstep; const char* b2 = last ? nB : cB + (size_t)(t + 2) * kstep;
            const char* a3 = a2 + kstep; const char* b3 = b2 + kstep;
            if (last && has_next) S.a_ready(nxt);
            PG8_LDB(B0, 0, 0); PG8_SCHED; PG8_LDA(At, 0, 0); PG8_STAGE(PG8_SA(1, 1), a1 + hstepA, voffA);
            PG8_WAIT_L(8); PG8_BAR; PG8_WAIT_L(0); PG8_MMA(0, 0, At, B0); PG8_BAR; PG8_SCHED;
            PG8_LDB(B1, 0, 1); PG8_STAGE(PG8_SB(0, 0), b2, voffB);
            PG8_BAR; PG8_WAIT_L(0); PG8_MMA(0, 1, At, B1); PG8_BAR;
            PG8_LDA(At, 0, 1); PG8_STAGE(PG8_SA(0, 0), a2, voffA);
            PG8_BAR; PG8_WAIT_L(0); PG8_MMA(1, 0, At, B0); PG8_BAR; PG8_SCHED;
            PG8_STAGE(PG8_SB(0, 1), b2 + hstepB, voffB);
            PG8_WAIT_V(6); PG8_BAR; PG8_MMA(1, 1, At, B1); PG8_BAR;
            PG8_LDB(B0, 1, 0); PG8_SCHED; PG8_LDA(At, 1, 0); PG8_STAGE(PG8_SA(0, 1), a2 + hstepA, voffA);
            PG8_WAIT_L(8); PG8_BAR; PG8_WAIT_L(0); PG8_MMA(0, 0, At, B0); PG8_BAR; PG8_SCHED;
            PG8_LDB(B1, 1, 1); PG8_STAGE(PG8_SB(1, 0), b3, voffB);
            PG8_BAR; PG8_WAIT_L(0); PG8_MMA(0, 1, At, B1); PG8_BAR;
            PG8_LDA(At, 1, 1); PG8_STAGE(PG8_SA(1, 0), a3, voffA);
            PG8_BAR; PG8_WAIT_L(0); PG8_MMA(1, 0, At, B0); PG8_BAR; PG8_SCHED;
            PG8_STAGE(PG8_SB(1, 1), b3 + hstepB, voffB);
            PG8_WAIT_V(6); PG8_BAR; PG8_MMA(1, 1, At, B1); PG8_BAR;
        }
        E(acc, cur, wr, wc, fr, fq); S.done(cur);
        if (!has_next) break;
#pragma unroll
        for (int a = 0; a < 2; ++a)
#pragma unroll
            for (int b = 0; b < 2; ++b)
#pragma unroll
                for (int m = 0; m < 4; ++m)
#pragma unroll
                    for (int n = 0; n < 2; ++n) acc[a][b][m][n] = (f32x4){0.f, 0.f, 0.f, 0.f};
        cur = nxt; cA = nA; cB = nB; ++ui;
    }
    PG8_WAIT_V(0);
    if (wr == 0) PG8_BAR;
    PG8_BAR;
#undef PG8_SA
#undef PG8_SB
#undef PG8_STAGE
#undef PG8_LDA
#undef PG8_LDB
#undef PG8_MMA
#undef PG8_WAIT_V
#undef PG8_WAIT_L
#undef PG8_BAR
#undef PG8_SCHED
}
}

struct AttnUnit {
    const bf16_t* Q; int ldq;
    const bf16_t* K; int ldk;
    const bf16_t* Kpe;
    const bf16_t* V; int ldv;
    bf16_t* O;
    int nkeys;
    int nt, ntreal, nfirst, base1, base2;
    float scale;
    int masked;
    int tq0;
    const float* rpb;
};

__host__ __device__ __forceinline__ int attn_nunits(int sect, int rnd) {
    if (rnd == 0) return sect == 2 ? 512 : 256;
    return sect == 0 ? 128 : sect == 1 ? 256 : sect == 2 ? 256 : 0;
}
__device__ __forceinline__ AttnUnit make_unit(int sect, int rnd, int idx, int l, bf16_t* z, bf16_t* qb, bf16_t* kvb, bf16_t* ob, const float* a_rpb) {
    AttnUnit U; U.Kpe = nullptr; U.masked = 0; U.tq0 = 0; U.rpb = nullptr;
    int tok0, kq0, kk0, h, grp;
    if (rnd == 0) {
        const int qblk = idx & 7; int lb;
        if (sect == 2) { h = (idx >> 3) & 15; lb = idx >> 7; } else { h = (idx >> 3) & 7; lb = idx >> 6; }
        tok0 = NP + lb * LSEQ + qblk * 256; kk0 = NP + lb * LKV; kq0 = kk0 + qblk * 256; U.nkeys = LKV;
        grp = sect == 0 ? 1 : sect == 1 ? 2 : sect == 2 ? 3 : 0;
        if (sect == 3) { U.masked = 1; U.tq0 = qblk * 256; U.rpb = a_rpb + (size_t)(l * 8 + h) * 465; }
    } else {
        int pb;
        if (sect == 2) { h = idx & 15; pb = idx >> 4; grp = 3; }
        else if (sect == 0) { h = idx & 7; pb = idx >> 3; grp = 1; }
        else { const int i2 = idx & 127; h = i2 & 7; pb = i2 >> 3; grp = idx < 128 ? 2 : 0; }
        tok0 = pb * 256; kk0 = tok0; kq0 = tok0; U.nkeys = PSEQ;
    }
    const bf16_t* zq = z + (size_t)kq0 * LDZ; const bf16_t* zk = z + (size_t)kk0 * LDZ;
    if (grp == 0) { U.Q = zq + ZC_AQ + h * 128; U.ldq = LDZ; U.K = zk + ZC_AK + h * 128; U.ldk = LDZ; U.V = zk + ZC_AV + h * 128; U.ldv = LDZ; U.scale = 0.08838834764831845f; U.O = ob + (size_t)tok0 * LDO + h * 128; }
    else if (grp == 1) { U.Q = qb + (size_t)kq0 * LDQB + h * 192; U.ldq = LDQB; U.K = kvb + (size_t)kk0 * LDKVB + h * 256; U.ldk = LDKVB; U.Kpe = zk + ZC_BKPE; U.V = kvb + (size_t)kk0 * LDKVB + h * 256 + 128; U.ldv = LDKVB;
        U.scale = 0.07216878364870323f; U.O = ob + (size_t)tok0 * LDO + 1024 + h * 128; }
    else if (grp == 2) { U.Q = zq + ZC_CQ + h * 128; U.ldq = LDZ; U.K = zk + ZC_CK + (h >> 2) * 128; U.ldk = LDZ; U.V = zk + ZC_CV + (h >> 2) * 128; U.ldv = LDZ; U.scale = 0.08838834764831845f; U.O = ob + (size_t)tok0 * LDO + 2048 + h * 128; }
    else { U.Q = zq + ZC_DQ + h * 64; U.ldq = LDZ; U.K = zk + ZC_DK + h * 64; U.ldk = LDZ; U.V = zk + ZC_DV + (h >> 1) * 128; U.ldv = LDZ; U.scale = 0.125f; U.O = ob + (size_t)tok0 * LDO + 3072 + h * 128; }
    if (U.masked) {
        const int r0 = U.tq0 >> 6; int lo = r0 - 4; lo = lo < 0 ? 0 : (lo > 24 ? 24 : lo); int hs = r0 + 3 - 4; hs = hs < 0 ? 0 : (hs > 24 ? 24 : hs); const int hiR = hs + 7;
        U.ntreal = 4 + (hiR - lo + 1); U.nt = (U.ntreal + 1) & ~1; U.nfirst = 4; U.base1 = 32; U.base2 = lo;
    } else { U.nt = U.nkeys / 64; U.ntreal = U.nt; U.nfirst = U.nt; U.base1 = 0; U.base2 = 0; }
    return U;
}

__device__ __forceinline__ void naive_unit(const AttnUnit& U, int DK, LAS float* sc_all, LAS float* q_all) {
    const int wid = threadIdx.x >> 6, lane = threadIdx.x & 63;
    LAS float* sc = sc_all + wid * 2304; LAS float* qf = q_all + wid * 192;
    const int nkeys = U.nkeys;
    for (int rr = 0; rr < 32; ++rr) {
        const int row = wid * 32 + rr;
        const bf16_t* qp = U.Q + (size_t)row * U.ldq;
        for (int d = lane; d < DK; d += 64) qf[d] = bf2f(qp[d]);
        LDS_WAIT(); asm volatile("" ::: "memory");
        float mx = -3e38f;
        const int t = U.tq0 + row, qr = t >> 6, qc = t & 63;
        int srw = qr - 4; srw = srw < 0 ? 0 : (srw > 24 ? 24 : srw); int scw = qc - 8; scw = scw < 0 ? 0 : (scw > 48 ? 48 : scw);
        for (int k0 = 0; k0 < nkeys; k0 += 64) {
            const int k = k0 + lane; const bf16_t* kp = U.K + (size_t)k * U.ldk; float dot = 0.f;
            const int d1 = DK < 128 ? DK : 128;
            for (int d = 0; d < d1; d += 8) { const u32x4 w = *(const u32x4*)(kp + d);
                dot += bflo(w.x) * qf[d] + bfhi(w.x) * qf[d + 1] + bflo(w.y) * qf[d + 2] + bfhi(w.y) * qf[d + 3] + bflo(w.z) * qf[d + 4] + bfhi(w.z) * qf[d + 5] + bflo(w.w) * qf[d + 6] + bfhi(w.w) * qf[d + 7]; }
            if (DK == 192) { const bf16_t* kp2 = U.Kpe + (size_t)k * LDZ;
                for (int d = 0; d < 64; d += 8) { const u32x4 w = *(const u32x4*)(kp2 + d); const int e = 128 + d;
                    dot += bflo(w.x) * qf[e] + bfhi(w.x) * qf[e + 1] + bflo(w.y) * qf[e + 2] + bfhi(w.y) * qf[e + 3] + bflo(w.z) * qf[e + 4] + bfhi(w.z) * qf[e + 5] + bflo(w.w) * qf[e + 6] + bfhi(w.w) * qf[e + 7]; } }
            float s = dot * U.scale;
            if (U.masked && k < LSEQ) { const int kr = k >> 6, kc = k & 63;
                const bool ok = kr >= srw && kr < srw + 8 && kc >= scw && kc < scw + 16;
                int dc = kc - qc; dc = dc < -15 ? -15 : (dc > 15 ? 15 : dc); dc += 15; const int dr = kr - qr + 7;
                const float b = U.rpb[ok ? dr * 31 + dc : 0];
                s = ok ? s + b : -3e38f; }
            sc[k] = s; mx = fmaxf(mx, s);
        }
        mx = wave_max(mx);
        LDS_WAIT(); asm volatile("" ::: "memory");
        float sum = 0.f;
        for (int k = lane; k < nkeys; k += 64) { const float s = sc[k]; const float p = s > -1e37f ? __expf(s - mx) : 0.f; sc[k] = p; sum += p; }
        sum = wave_sum(sum);
        LDS_WAIT(); asm volatile("" ::: "memory");
        const float inv = 1.0f / sum;
        float a0 = 0.f, a1 = 0.f;
        for (int k = 0; k < nkeys; ++k) { const float p = sc[k]; const bf16_t* vp = U.V + (size_t)k * U.ldv; a0 += p * bf2f(vp[lane]); a1 += p * bf2f(vp[64 + lane]); }
        bf16_t* op = U.O + (size_t)row * LDO; op[lane] = (bf16_t)f2bf(a0 * inv); op[64 + lane] = (bf16_t)f2bf(a1 * inv);
        LDS_WAIT(); asm volatile("" ::: "memory");
    }
}

namespace att {
constexpr float THR = 8.f;
#define SBAR() __builtin_amdgcn_sched_barrier(0)
__device__ __forceinline__ int crow(int r, int hi) { return (r & 3) + 8 * (r >> 2) + 4 * hi; }
__device__ __forceinline__ void partialSM(f32x16& p0, f32x16& p1, float& m_reg, float& mn, float& alpha, float C, float thr_raw) {
    float pmax = p0[0];
#pragma unroll
    for (int r = 1; r < 16; ++r) pmax = fmaxf(pmax, p0[r]);
#pragma unroll
    for (int r = 0; r < 16; ++r) pmax = fmaxf(pmax, p1[r]);
    { auto rr = __builtin_amdgcn_permlane32_swap(__float_as_uint(pmax), __float_as_uint(pmax), false, false);
      pmax = fmaxf(__uint_as_float(rr[0]), __uint_as_float(rr[1])); }
    if (__builtin_expect(__all(pmax - m_reg <= thr_raw), 1)) { mn = m_reg; alpha = 1.f; }
    else { mn = fmaxf(m_reg, pmax); alpha = __builtin_amdgcn_exp2f((m_reg - mn) * C); m_reg = mn; }
    const float mnC = -mn * C;
#pragma unroll
    for (int r = 0; r < 16; ++r) p0[r] = fmaf(p0[r], C, mnC);
#pragma unroll
    for (int r = 0; r < 16; ++r) p1[r] = fmaf(p1[r], C, mnC);
#pragma unroll
    for (int r = 0; r < 16; ++r) p0[r] = __builtin_amdgcn_exp2f(p0[r]);
}
__device__ __forceinline__ void finishSM(f32x16& p0, f32x16& p1, float alpha, float& l_reg, bf16x8& pa0, bf16x8& pa1, bf16x8& pa2, bf16x8& pa3) {
#pragma unroll
    for (int r = 0; r < 16; ++r) p1[r] = __builtin_amdgcn_exp2f(p1[r]);
    float ps = 0;
#pragma unroll
    for (int r = 0; r < 16; ++r) ps += p0[r];
#pragma unroll
    for (int r = 0; r < 16; ++r) ps += p1[r];
    { auto rr = __builtin_amdgcn_permlane32_swap(__float_as_uint(ps), __float_as_uint(ps), false, false);
      ps = __uint_as_float(rr[0]) + __uint_as_float(rr[1]); }
    l_reg = l_reg * alpha + ps;
#define PK4(P, BASE, OUT) do { unsigned a0 = cvt_pk_bf16(P[BASE + 0], P[BASE + 1]), a1 = cvt_pk_bf16(P[BASE + 2], P[BASE + 3]);   \
    unsigned b0 = cvt_pk_bf16(P[BASE + 4], P[BASE + 5]), b1 = cvt_pk_bf16(P[BASE + 6], P[BASE + 7]);                              \
    auto r0 = __builtin_amdgcn_permlane32_swap(a0, b0, false, false); auto r1 = __builtin_amdgcn_permlane32_swap(a1, b1, false, false); \
    u32x4 w = {r0[0], r1[0], r0[1], r1[1]}; OUT = *reinterpret_cast<bf16x8*>(&w); } while (0)
    PK4(p0, 0, pa0); PK4(p0, 8, pa1); PK4(p1, 0, pa2); PK4(p1, 8, pa3);
#undef PK4
}
template <int DK> __device__ __forceinline__ int kswz(int row, int colB) { return row * (DK * 2) + (colB ^ ((row & 7) << 4)); }
template <int DK> __device__ __forceinline__ void qkt(f32x16& p0, f32x16& p1, const char* Ks, const bf16x8* qr, const char* qlds, int r32, int hi) {
    p0 = f32x16{}; p1 = f32x16{};
#pragma unroll
    for (int d0 = 0; d0 < DK / 16; ++d0) { const int cb = (d0 * 16 + hi * 8) * 2;
        const bf16x8 b0 = *reinterpret_cast<const bf16x8*>(Ks + kswz<DK>(r32, cb));
        const bf16x8 b1 = *reinterpret_cast<const bf16x8*>(Ks + kswz<DK>(32 + r32, cb));
        bf16x8 q; if (d0 < 8) q = qr[d0]; else q = *reinterpret_cast<const bf16x8*>(qlds + (d0 - 8) * 8192);
        p0 = __builtin_amdgcn_mfma_f32_32x32x16_bf16(b0, q, p0, 0, 0, 0);
        p1 = __builtin_amdgcn_mfma_f32_32x32x16_bf16(b1, q, p1, 0, 0, 0); }
}
__device__ __forceinline__ int v_st(int k, int c) { const int kk = (k & ~0xC) | ((k & 4) << 1) | ((k & 8) >> 1); return ((kk >> 3) * 4 + (c >> 5)) * 512 + ((kk & 7) * 32 + (c & 31)) * 2; }
__device__ __forceinline__ int v_rd_base(int lane) { return ((lane & 3) << 3) | (((lane >> 2) & 3) << 6) | (((lane >> 4) & 1) << 5) | (((lane >> 5) & 1) << 8); }
constexpr int v_rd_off(int d0, int ks, int half) { return d0 * 512 + ks * 4096 + half * 2048; }
template <int OFF> __device__ __forceinline__ s16x4 tr_read(int vb) {
    s16x4 r; asm volatile("ds_read_b64_tr_b16 %0, %1 offset:%2" : "=&v"(r) : "v"(vb), "i"(OFF) : "memory"); return r;
}
template <int D0> __device__ __forceinline__ void pv_one(f32x16& od, int vb, bf16x8 pa0, bf16x8 pa1, bf16x8 pa2, bf16x8 pa3) {
    const s16x4 l0 = tr_read<v_rd_off(D0, 0, 0)>(vb), h0 = tr_read<v_rd_off(D0, 0, 1)>(vb), l1 = tr_read<v_rd_off(D0, 1, 0)>(vb), h1 = tr_read<v_rd_off(D0, 1, 1)>(vb);
    const s16x4 l2 = tr_read<v_rd_off(D0, 2, 0)>(vb), h2 = tr_read<v_rd_off(D0, 2, 1)>(vb), l3 = tr_read<v_rd_off(D0, 3, 0)>(vb), h3 = tr_read<v_rd_off(D0, 3, 1)>(vb);
    asm volatile("s_waitcnt lgkmcnt(0)" ::: "memory"); SBAR();
#define PK(L, H) (bf16x8){L[0], L[1], L[2], L[3], H[0], H[1], H[2], H[3]}
    od = __builtin_amdgcn_mfma_f32_32x32x16_bf16(pa0, PK(l0, h0), od, 0, 0, 0);
    od = __builtin_amdgcn_mfma_f32_32x32x16_bf16(pa1, PK(l1, h1), od, 0, 0, 0);
    od = __builtin_amdgcn_mfma_f32_32x32x16_bf16(pa2, PK(l2, h2), od, 0, 0, 0);
    od = __builtin_amdgcn_mfma_f32_32x32x16_bf16(pa3, PK(l3, h3), od, 0, 0, 0);
#undef PK
}
__device__ __forceinline__ void pv_d0(f32x16* o, int vb, bf16x8 pa0, bf16x8 pa1, bf16x8 pa2, bf16x8 pa3) {
    pv_one<0>(o[0], vb, pa0, pa1, pa2, pa3); pv_one<1>(o[1], vb, pa0, pa1, pa2, pa3); pv_one<2>(o[2], vb, pa0, pa1, pa2, pa3); pv_one<3>(o[3], vb, pa0, pa1, pa2, pa3);
}

template <int DK, bool MASK>
__device__ __forceinline__ void attn_body(const AttnUnit& U, char* lds) {
    constexpr int SHM_V = 16384, SHM_K = 64 * DK * 2, ND0 = DK / 16, NKC = DK / 64, CPR = DK / 8, SD = 1;
    int tid_ = threadIdx.x; asm volatile("" : "+v"(tid_));
    const int tid = tid_, wid = __builtin_amdgcn_readfirstlane(tid >> 6), lane = tid & 63, r32 = lane & 31, hi = lane >> 5;
    char* V_lds = lds; char* K_lds = lds + 2 * SHM_V;
    float* wsf = (float*)(lds + 2 * SHM_V + 2 * SHM_K) + wid * 64; float* li_l = wsf; float* al_l = wsf + 32;
    float* rpb_l = (float*)(lds + 2 * SHM_V + 2 * SHM_K + 2048);
    const float Cc = U.scale * 1.4426950408889634f, thr_raw = THR / U.scale;
    constexpr int NQR = ND0 < 8 ? ND0 : 8;
    const char* qlds = lds + 2 * SHM_V + 2 * SHM_K + 4096 + tid * 16;
    float m_reg = -1e30f, l_reg = 0; f32x16 o[4] = {}; bf16x8 qr[NQR];
    { const bf16_t* Qw = U.Q + (long)(wid * 32 + r32) * U.ldq + hi * 8;
#pragma unroll
      for (int d0 = 0; d0 < NQR; ++d0) qr[d0] = *reinterpret_cast<const bf16x8*>(Qw + d0 * 16);
#pragma unroll
      for (int d0 = 8; d0 < ND0; ++d0) *(bf16x8*)(lds + 2 * SHM_V + 2 * SHM_K + 4096 + tid * 16 + (d0 - 8) * 8192) = *reinterpret_cast<const bf16x8*>(Qw + d0 * 16); }
    int qrw = 0, srw = 0, qc = 0; unsigned vm0 = 0, vm1 = 0;
    if constexpr (MASK) {
        qrw = (U.tq0 >> 6) + (wid >> 1); srw = qrw - 4; srw = srw < 0 ? 0 : (srw > 24 ? 24 : srw);
        qc = 32 * (wid & 1) + r32; int scq = qc - 8; scq = scq < 0 ? 0 : (scq > 48 ? 48 : scq);
#pragma unroll
        for (int r = 0; r < 16; ++r) { const int k0 = crow(r, hi), k1 = 32 + k0; vm0 |= (unsigned)(k0 >= scq && k0 < scq + 16) << r; vm1 |= (unsigned)(k1 >= scq && k1 < scq + 16) << r; }
        const float isc = 1.0f / U.scale;
        if (tid < 465) rpb_l[tid] = U.rpb[tid] * isc;
    }
    const int sr = tid >> 4, sc = (tid & 15) * 8, vst0 = v_st(sr, sc), vst1 = v_st(32 + sr, sc);
    const int vo0 = sr * U.ldv + sc, vo1 = (32 + sr) * U.ldv + sc, vts = 64 * U.ldv;
    int ko[NKC], kst[NKC]; bool kpe[NKC];
#pragma unroll
    for (int i = 0; i < NKC; ++i) { const int c = tid + i * 512, row = c / CPR, cc = c % CPR;
        kpe[i] = (DK == 192 && cc >= 16);
        ko[i] = kpe[i] ? row * LDZ + (cc - 16) * 8 : row * U.ldk + cc * 8;
        kst[i] = kswz<DK>(row, cc * 16); }
    const int ktsn = 64 * U.ldk, ktsp = 64 * LDZ;
    const int vb0 = (int)(uintptr_t)V_lds + v_rd_base(lane);
    struct Slot { bf16x8 vs0, vs1, ks[NKC]; } sl[SD];
#define KT_OF(j) ((j) < U.nfirst ? U.base1 + (j) : U.base2 + (j) - U.nfirst)
#define SLOAD(i, j) do { const int kt_ = KT_OF(j); sl[i].vs0 = *reinterpret_cast<const bf16x8*>(U.V + (vo0 + kt_ * vts)); sl[i].vs1 = *reinterpret_cast<const bf16x8*>(U.V + (vo1 + kt_ * vts)); \
    _Pragma("unroll") for (int c_ = 0; c_ < NKC; ++c_) sl[i].ks[c_] = kpe[c_] ? *reinterpret_cast<const bf16x8*>(U.Kpe + (ko[c_] + kt_ * ktsp)) : *reinterpret_cast<const bf16x8*>(U.K + (ko[c_] + kt_ * ktsn)); } while (0)
#define SWRITE(b, i) do { *(bf16x8*)(V_lds + (b) * SHM_V + vst0) = sl[i].vs0; *(bf16x8*)(V_lds + (b) * SHM_V + vst1) = sl[i].vs1; \
    _Pragma("unroll") for (int c_ = 0; c_ < NKC; ++c_) *(bf16x8*)(K_lds + (b) * SHM_K + kst[c_]) = sl[i].ks[c_]; } while (0)
#define SWAIT() do { if constexpr (SD == 1) asm volatile("s_waitcnt vmcnt(0)" ::: "memory"); else if constexpr (NKC == 1) asm volatile("s_waitcnt vmcnt(3)" ::: "memory"); else asm volatile("s_waitcnt vmcnt(4)" ::: "memory"); } while (0)
#define RESC(a) do { if (__any((a) < 1.f)) { if (hi == 0) al_l[r32] = (a); asm volatile("s_waitcnt lgkmcnt(0)" ::: "memory"); \
    _Pragma("unroll") for (int d = 0; d < 4; ++d) _Pragma("unroll") for (int r = 0; r < 16; ++r) o[d][r] *= al_l[crow(r, hi)]; } } while (0)
#define MASKB(P0, P1, j) do { if constexpr (MASK) { const int kt_ = KT_OF(j); \
    if ((j) >= U.ntreal || (kt_ < 32 && (kt_ < srw || kt_ > srw + 7))) { _Pragma("unroll") for (int r = 0; r < 16; ++r) { P0[r] = -1e30f; P1[r] = -1e30f; } } \
    else if (kt_ < 32) { const int bi_ = (kt_ - qrw + 7) * 31 + 15 - qc; \
        _Pragma("unroll") for (int r = 0; r < 16; ++r) { const int kc_ = crow(r, hi); const bool v0_ = (vm0 >> r) & 1u, v1_ = (vm1 >> r) & 1u; \
            const float b0_ = rpb_l[v0_ ? bi_ + kc_ : 0], b1_ = rpb_l[v1_ ? bi_ + kc_ + 32 : 0]; \
            P0[r] = v0_ ? P0[r] + b0_ : -1e30f; P1[r] = v1_ ? P1[r] + b1_ : -1e30f; } } } } while (0)
    f32x16 pA0, pA1, pB0, pB1; float mnA, mnB, alA, alB; bf16x8 pa0, pa1, pa2, pa3; const int NT = U.nt;
    constexpr int SE = 0, SO = SD - 1;
    SLOAD(SE, 0); asm volatile("s_waitcnt vmcnt(0)" ::: "memory"); SWRITE(0, SE); __syncthreads();
    qkt<DK>(pA0, pA1, K_lds, qr, qlds, r32, hi); MASKB(pA0, pA1, 0); partialSM(pA0, pA1, m_reg, mnA, alA, Cc, thr_raw);
    SLOAD(SO, 1); if constexpr (SD == 2) { if (2 < NT) SLOAD(SE, 2); }
    SWAIT(); SWRITE(1, SO); __syncthreads();
    for (int j = 1; j + 1 < NT; j += 2) {
        SBAR(); qkt<DK>(pB0, pB1, K_lds + SHM_K, qr, qlds, r32, hi);
        finishSM(pA0, pA1, alA, l_reg, pa0, pa1, pa2, pa3); SBAR();
        SLOAD(SO, j + SD); SBAR();
        pv_d0(o, vb0, pa0, pa1, pa2, pa3); MASKB(pB0, pB1, j); partialSM(pB0, pB1, m_reg, mnB, alB, Cc, thr_raw);
        __syncthreads(); SWAIT(); SWRITE(0, SE);
        RESC(alB); __syncthreads();
        SBAR(); qkt<DK>(pA0, pA1, K_lds, qr, qlds, r32, hi);
        finishSM(pB0, pB1, alB, l_reg, pa0, pa1, pa2, pa3); SBAR();
        if (SD == 1 || j + 3 < NT) SLOAD(SE, j + 1 + SD); SBAR();
        pv_d0(o, vb0 + SHM_V, pa0, pa1, pa2, pa3); MASKB(pA0, pA1, j + 1); partialSM(pA0, pA1, m_reg, mnA, alA, Cc, thr_raw);
        __syncthreads(); SWAIT(); SWRITE(1, SO);
        RESC(alA); __syncthreads();
    }
    SBAR(); qkt<DK>(pB0, pB1, K_lds + SHM_K, qr, qlds, r32, hi);
    finishSM(pA0, pA1, alA, l_reg, pa0, pa1, pa2, pa3); SBAR();
    pv_d0(o, vb0, pa0, pa1, pa2, pa3); MASKB(pB0, pB1, NT - 1); partialSM(pB0, pB1, m_reg, mnB, alB, Cc, thr_raw);
    __syncthreads(); RESC(alB);
    finishSM(pB0, pB1, alB, l_reg, pa0, pa1, pa2, pa3); SBAR();
    pv_d0(o, vb0 + SHM_V, pa0, pa1, pa2, pa3);
    if (hi == 0) li_l[r32] = l_reg; asm volatile("s_waitcnt lgkmcnt(0)" ::: "memory");
    bf16_t* Ow = U.O + (long)(wid * 32) * LDO;
#pragma unroll
    for (int r = 0; r < 16; ++r) { const int orow = crow(r, hi); const float rl = __builtin_amdgcn_rcpf(li_l[orow]);
#pragma unroll
        for (int d0 = 0; d0 < 4; ++d0) Ow[(long)orow * LDO + d0 * 32 + r32] = (bf16_t)f2bf(o[d0][r] * rl); }
    __syncthreads();
#undef KT_OF
#undef SLOAD
#undef SWRITE
#undef SWAIT
#undef RESC
#undef MASKB
}
}

#define XB_TMO      128
#define XB_XCNT(j)  (256  + 64 * (j))
#define XB_XSUB(j)  (1280 + 64 * (j))
#define XB_XGEN(j)  (2304 + 64 * (j))
#define XB_TOP      3328
#define XB_TOPGEN   3392
#define XCD_BAR_WORDS 3456
#define XB_SPIN_CAP (1u << 22)
__device__ __forceinline__ unsigned xb_ld(unsigned* p)              { return __hip_atomic_load(p, __ATOMIC_RELAXED, __HIP_MEMORY_SCOPE_AGENT); }
__device__ __forceinline__ unsigned xb_add(unsigned* p, unsigned v) { return __hip_atomic_fetch_add(p, v, __ATOMIC_RELAXED, __HIP_MEMORY_SCOPE_AGENT); }
__device__ __forceinline__ unsigned xb_xcc_id() { return (unsigned)__builtin_amdgcn_s_getreg((3 << 11) | 20) & 0xFu; }
#define XB_SPIN(cond, bar) do { unsigned _sp = 0; while (cond) { __builtin_amdgcn_s_sleep(1); \
    if ((++_sp & 255u) == 0u) { if (xb_ld(&(bar)[XB_TMO])) break; if (_sp > XB_SPIN_CAP) { atomicAdd(&(bar)[XB_TMO], 1u); break; } } } } while (0)
struct XcdBarrier { unsigned* bar; unsigned x; volatile LAS unsigned* st; };
__device__ __forceinline__ XcdBarrier xcd_barrier_post(unsigned* bar, volatile LAS unsigned* st) {
    XcdBarrier b; b.bar = bar; b.x = xb_xcc_id(); b.st = st;
    if (threadIdx.x == 0) (void)xb_add(&bar[XB_XCNT(b.x)], 1u);
    return b;
}
__device__ __forceinline__ void xcd_barrier_complete(unsigned* bar, unsigned x, unsigned& nloc, unsigned& nx) {
    const unsigned G = gridDim.x * gridDim.y * gridDim.z;
    unsigned sum, cnt, mine, sp = 0u;
    for (;;) {
        sum = 0u; cnt = 0u; mine = 0u;
#pragma unroll
        for (unsigned j = 0; j < 16; ++j) { const unsigned c = xb_ld(&bar[XB_XCNT(j)]); sum += c; cnt += (c > 0u) ? 1u : 0u; mine = (j == x) ? c : mine; }
        if (sum == G) break;
        __builtin_amdgcn_s_sleep(1);
        if ((++sp & 255u) == 0u) { if (xb_ld(&bar[XB_TMO])) break; if (sp > XB_SPIN_CAP) { atomicAdd(&bar[XB_TMO], 1u); break; } }
    }
    nloc = mine > 0u ? mine : 1u; nx = cnt > 0u ? cnt : 1u;
}
__device__ __forceinline__ void xcd_barrier(const XcdBarrier& b) {
    asm volatile("s_waitcnt vmcnt(0)" ::: "memory");
    __syncthreads();
    if (threadIdx.x == 0) {
        unsigned* bar = b.bar;
        __builtin_amdgcn_s_waitcnt(0);
        unsigned nloc = b.st[0], nx = b.st[1];
        if (nloc == 0u) { xcd_barrier_complete(bar, b.x, nloc, nx); b.st[0] = nloc; b.st[1] = nx; }
        const unsigned old = xb_add(&bar[XB_XSUB(b.x)], 1u);
        const unsigned gen = old / nloc;
        if (old + 1u == (gen + 1u) * nloc) {
            __builtin_amdgcn_fence(__ATOMIC_RELEASE, "agent");
            asm volatile("s_waitcnt vmcnt(0)" ::: "memory");
            const unsigned og = xb_add(&bar[XB_TOP], 1u);
            const unsigned tg = og / nx;
            if (og + 1u == (tg + 1u) * nx) xb_add(&bar[XB_TOPGEN], 1u);
            else XB_SPIN(xb_ld(&bar[XB_TOPGEN]) == tg, bar);
            __builtin_amdgcn_fence(__ATOMIC_ACQUIRE, "agent");
            xb_add(&bar[XB_XGEN(b.x)], 1u);
            asm volatile("s_waitcnt vmcnt(0)" ::: "memory");
        } else {
            XB_SPIN(xb_ld(&bar[XB_XGEN(b.x)]) == gen, bar);
            __builtin_amdgcn_fence(__ATOMIC_ACQUIRE, "agent");
            asm volatile("s_waitcnt vmcnt(0)" ::: "memory");
        }
    }
    __syncthreads();
}

struct Params { const float* in[30]; float* out; unsigned char* ws; int ph_lo, ph_hi; };
enum { I_XP = 0, I_XS, I_CAK, I_CAV, I_CBCKV, I_CBKPE, I_CCK, I_CCV, I_CDK, I_CDV, I_C, I_CCTX, I_NORMG, I_WADA, I_BADA, I_WIN, I_WOUT, I_RPB, I_BQN, I_WUQ, I_BKVN, I_WUKV,
       I_CQN, I_CKN, I_LQ1, I_LK1, I_LQ2, I_LK2, I_SUBLN, I_FNG };

__device__ __forceinline__ void transpose_item(const float* __restrict__ W, int ldw, int k0, int nsrc0, bf16_t* __restrict__ WT, int K, int ndst0, LAS float* scr, int lane) {
#pragma unroll 8
    for (int i = 0; i < 32; ++i) { const int kk = 2 * i + (lane >> 5); scr[kk * 33 + (lane & 31)] = W[(size_t)(k0 + kk) * ldw + nsrc0 + (lane & 31)]; }
    LDS_WAIT(); asm volatile("" ::: "memory");
    const int c = lane & 7;
#pragma unroll
    for (int j = 0; j < 4; ++j) { const int n = (lane >> 3) + 8 * j; const LAS float* s = scr + (8 * c) * 33 + n;
        u32x4 o; o.x = pk2(s[0 * 33], s[1 * 33]); o.y = pk2(s[2 * 33], s[3 * 33]); o.z = pk2(s[4 * 33], s[5 * 33]); o.w = pk2(s[6 * 33], s[7 * 33]);
        *(u32x4*)(WT + (size_t)(ndst0 + n) * K + k0 + 8 * c) = o; }
    LDS_WAIT(); asm volatile("" ::: "memory");
}

#define PH_IDS() int tid_ = threadIdx.x; asm volatile("" : "+v"(tid_)); const int lane = tid_ & 63, wave = __builtin_amdgcn_readfirstlane(tid_ >> 6), NGW = gridDim.x * NWAVES, gw = blockIdx.x * NWAVES + wave; (void)wave
__device__ __forceinline__ void ph_prologue(const Params& P, LAS unsigned char* lds) {
    PH_IDS();
    unsigned char* ws = P.ws;
    for (int it = gw; it < 2048; it += NGW) {
        const int l = it >> 10, dch = (it >> 4) & 63, cb = it & 15;
        const float* W = P.in[I_WADA] + (size_t)l * DM * 12288 + (size_t)(dch * 64) * 12288 + cb * 768 + lane * 4;
        f32x4 acc[5][3];
#pragma unroll
        for (int v = 0; v < 5; ++v)
#pragma unroll
            for (int j = 0; j < 3; ++j) acc[v][j] = (f32x4){0.f, 0.f, 0.f, 0.f};
#pragma unroll 2
        for (int r = 0; r < 64; ++r) {
            const int d = dch * 64 + r;
            float s[5]; s[0] = silu_f(P.in[I_CCTX][d]);
#pragma unroll
            for (int v = 1; v < 5; ++v) s[v] = silu_f(P.in[I_C][(v - 1) * DM + d]);
            f32x4 w[3];
#pragma unroll
            for (int j = 0; j < 3; ++j) w[j] = *(const f32x4*)(W + (size_t)r * 12288 + j * 256);
#pragma unroll
            for (int v = 0; v < 5; ++v)
#pragma unroll
                for (int j = 0; j < 3; ++j) acc[v][j] += w[j] * s[v];
        }
        float* mod = (float*)(ws + WS_CTL + CTL_MOD) + (size_t)l * 5 * 12288;
#pragma unroll
        for (int j = 0; j < 3; ++j) { const int col = cb * 768 + j * 256 + lane * 4;
            f32x4 b = (f32x4){0.f, 0.f, 0.f, 0.f}; if (dch == 0) b = *(const f32x4*)(P.in[I_BADA] + (size_t)l * 12288 + col);
#pragma unroll
            for (int v = 0; v < 5; ++v) { const f32x4 a = acc[v][j] + b; float* mp = mod + (size_t)v * 12288 + col;
                atomicAdd(mp + 0, a[0]); atomicAdd(mp + 1, a[1]); atomicAdd(mp + 2, a[2]); atomicAdd(mp + 3, a[3]); } }
    }
    if (gw == NGW - 1) {
        float* tab = (float*)(ws + WS_TAB);
        for (int i = lane; i < 1024; i += 64) { const int pos = i >> 4, j = i & 15; const float fr = powf(10000.0f, -(float)j / 16.0f), a = (float)pos * fr; tab[TB_C64 + i] = cosf(a); tab[TB_S64 + i] = sinf(a); }
        for (int i = lane; i < 2048; i += 64) { const int pos = i >> 5, j = i & 31; const float fr = powf(10000.0f, -(float)j / 32.0f), a = (float)pos * fr; tab[TB_C128 + i] = cosf(a); tab[TB_S128 + i] = sinf(a); }
        for (int l = 0; l < 2; ++l) {
            const float d1 = wave_sum(P.in[I_LQ1][l * 64 + lane] * P.in[I_LK1][l * 64 + lane]), d2 = wave_sum(P.in[I_LQ2][l * 64 + lane] * P.in[I_LK2][l * 64 + lane]);
            const float lam_init = 0.8f - 0.6f * expf(-0.3f * (float)l);
            if (lane == 0) { tab[TB_LAM + 2 * l] = expf(d1) - expf(d2) + lam_init; tab[TB_LAM + 2 * l + 1] = lam_init; }
        }
    }
    LAS float* scr = (LAS float*)(lds + wave * 16384);
    constexpr int IT_IN = 64 * 410, IT_OUT = 64 * 128, IT_UQ = 12 * 48, IT_UKV = 8 * 64, IT_PAD = 192, IT_L = IT_IN + IT_OUT + IT_UQ + IT_UKV + IT_PAD;
    for (int it = gw; it < 2 * IT_L; it += NGW) {
        const int l = it / IT_L; int r = it - l * IT_L;
        if (r < IT_IN) { const int kb = r / 410, nb = r - kb * 410, nn = nb * 32; const int ns = nn < 5376 ? nn : (nn < 13056 ? nn + 64 : nn - 13056 + 5376);
            transpose_item(P.in[I_WIN] + (size_t)l * DM * INC, INC, kb * 64, ns, (bf16_t*)(ws + WS_BT1 + l * BT1_L), DM, nn, scr, lane); continue; }
        r -= IT_IN;
        if (r < IT_OUT) { const int kb = r >> 7, nb = r & 127; transpose_item(P.in[I_WOUT] + (size_t)l * DM * DM, DM, kb * 64, nb * 32, (bf16_t*)(ws + WS_BT2 + l * BT2_L), DM, nb * 32, scr, lane); continue; }
        r -= IT_OUT;
        if (r < IT_UQ) { const int kb = r / 48, nb = r - kb * 48; transpose_item(P.in[I_WUQ] + (size_t)l * 768 * 1536, 1536, kb * 64, nb * 32, (bf16_t*)(ws + WS_BUQ + l * BUQ_L), 768, nb * 32, scr, lane); continue; }
        r -= IT_UQ;
        if (r < IT_UKV) { const int kb = r >> 6, nb = r & 63; transpose_item(P.in[I_WUKV] + (size_t)l * 512 * 2048, 2048, kb * 64, nb * 32, (bf16_t*)(ws + WS_BUKV + l * BUKV_L), 512, nb * 32, scr, lane); continue; }
        r -= IT_UKV;
        { u32x4* p = (u32x4*)((bf16_t*)(ws + WS_BT1 + l * BT1_L) + (size_t)(INC + r) * DM) + lane;
#pragma unroll
          for (int j = 0; j < 8; ++j) p[64 * j] = (u32x4){0u, 0u, 0u, 0u}; }
    }
}

__device__ __forceinline__ void ph_norm(const Params& P, int l) {
    PH_IDS();
    const float* mod = (const float*)(P.ws + WS_CTL + CTL_MOD) + (size_t)l * 5 * 12288;
    const float* g = P.in[I_NORMG] + (size_t)l * DM;
    bf16_t* H = (bf16_t*)(P.ws + WS_H);
    for (int tok = gw; tok < NTOK; tok += NGW) {
        const float* xr = l == 0 ? (tok < NP ? P.in[I_XP] + (size_t)tok * DM : P.in[I_XS] + (size_t)(tok - NP) * DM) : (const float*)(P.ws + WS_X) + (size_t)tok * DM;
        const int v = tok < NP ? 0 : 1 + ((tok - NP) >> 11);
        const float* mv = mod + (size_t)v * 12288;
        f32x4 x[16]; float ss = 0.f;
#pragma unroll
        for (int j = 0; j < 16; ++j) { x[j] = *(const f32x4*)(xr + (j * 64 + lane) * 4); ss += (x[j][0] * x[j][0] + x[j][1] * x[j][1]) + (x[j][2] * x[j][2] + x[j][3] * x[j][3]); }
        const float rstd = 1.0f / sqrtf(wave_sum(ss) * (1.0f / DM) + EPS);
        bf16_t* hr = H + (size_t)tok * DM;
#pragma unroll
        for (int j = 0; j < 16; ++j) { const int c = (j * 64 + lane) * 4; const f32x4 gg = *(const f32x4*)(g + c), sh = *(const f32x4*)(mv + c), scl = *(const f32x4*)(mv + 4096 + c);
            const f32x4 y = (x[j] * rstd) * gg * (scl + 1.0f) + sh;
            u32x2 w; w.x = pk2(y[0], y[1]); w.y = pk2(y[2], y[3]); *(u32x2*)(hr + c) = w; }
    }
}

__device__ __forceinline__ void ld16(const bf16_t* p, float (&x)[16]) { const u32x4 a = *(const u32x4*)p, b = *(const u32x4*)(p + 8);
    x[0] = bflo(a.x); x[1] = bfhi(a.x); x[2] = bflo(a.y); x[3] = bfhi(a.y); x[4] = bflo(a.z); x[5] = bfhi(a.z); x[6] = bflo(a.w); x[7] = bfhi(a.w);
    x[8] = bflo(b.x); x[9] = bfhi(b.x); x[10] = bflo(b.y); x[11] = bfhi(b.y); x[12] = bflo(b.z); x[13] = bfhi(b.z); x[14] = bflo(b.w); x[15] = bfhi(b.w); }
__device__ __forceinline__ void st16(bf16_t* p, const float (&x)[16]) { u32x4 a, b; a.x = pk2(x[0], x[1]); a.y = pk2(x[2], x[3]); a.z = pk2(x[4], x[5]); a.w = pk2(x[6], x[7]);
    b.x = pk2(x[8], x[9]); b.y = pk2(x[10], x[11]); b.z = pk2(x[12], x[13]); b.w = pk2(x[14], x[15]); *(u32x4*)p = a; *(u32x4*)(p + 8) = b; }
__device__ __forceinline__ void st16f(float* p, const float (&x)[16]) {
#pragma unroll
    for (int j = 0; j < 4; ++j) *(f32x4*)(p + 4 * j) = (f32x4){x[4 * j], x[4 * j + 1], x[4 * j + 2], x[4 * j + 3]}; }
__device__ __forceinline__ void ld4(const bf16_t* p, float (&x)[4]) { const u32x2 a = *(const u32x2*)p; x[0] = bflo(a.x); x[1] = bfhi(a.x); x[2] = bflo(a.y); x[3] = bfhi(a.y); }
__device__ __forceinline__ void st4(bf16_t* p, const float (&x)[4]) { u32x2 a; a.x = pk2(x[0], x[1]); a.y = pk2(x[2], x[3]); *(u32x2*)p = a; }
__device__ __forceinline__ void cvt16(const float* src, bf16_t* dst) { float x[16];
#pragma unroll
    for (int j = 0; j < 4; ++j) { const f32x4 v = *(const f32x4*)(src + 4 * j); x[4 * j] = v[0]; x[4 * j + 1] = v[1]; x[4 * j + 2] = v[2]; x[4 * j + 3] = v[3]; }
    st16(dst, x); }

__device__ __forceinline__ void ph_post(const Params& P, int l) {
    PH_IDS();
    bf16_t* Z = (bf16_t*)(P.ws + WS_Z);
    const float* tab = (const float*)(P.ws + WS_TAB);
    float* out = P.out;
    for (int r = gw; r < NKV; r += NGW) {
        bf16_t* zr = Z + (size_t)r * LDZ;
        bool lat = false; int t = 0, pb = 0, lb = 0, cp = -1;
        if (r < NP) { pb = r >> 8; t = r & 255; }
        else { const int rr = r - NP; lb = rr / LKV; const int s = rr - lb * LKV; if (s < LSEQ) { lat = true; t = s; } else cp = s - LSEQ; }
        if (cp >= 0) {
            const size_t ci = (size_t)(lb * 2 + l) * PAST + cp;
            cvt16(P.in[I_CAK] + ci * 1024 + lane * 16, zr + ZC_AK + lane * 16);
            cvt16(P.in[I_CAV] + ci * 1024 + lane * 16, zr + ZC_AV + lane * 16);
            cvt16(P.in[I_CDK] + ci * 1024 + lane * 16, zr + ZC_DK + lane * 16);
            cvt16(P.in[I_CDV] + ci * 1024 + lane * 16, zr + ZC_DV + lane * 16);
            { const f32x4 a = *(const f32x4*)(P.in[I_CCK] + ci * 256 + lane * 4); float x[4] = {a[0], a[1], a[2], a[3]}; st4(zr + ZC_CK + lane * 4, x); }
            { const f32x4 a = *(const f32x4*)(P.in[I_CCV] + ci * 256 + lane * 4); float x[4] = {a[0], a[1], a[2], a[3]}; st4(zr + ZC_CV + lane * 4, x); }
            { const f32x4 a = *(const f32x4*)(P.in[I_CBCKV] + ci * 512 + lane * 8), b = *(const f32x4*)(P.in[I_CBCKV] + ci * 512 + lane * 8 + 4);
              u32x4 w; w.x = pk2(a[0], a[1]); w.y = pk2(a[2], a[3]); w.z = pk2(b[0], b[1]); w.w = pk2(b[2], b[3]); *(u32x4*)(zr + ZC_BCKV + lane * 8) = w; }
            zr[ZC_BKPE + lane] = (bf16_t)f2bf(P.in[I_CBKPE][ci * 64 + lane]);
            continue;
        }
        const size_t po = (size_t)(pb * 2 + l) * PSEQ + t;
        const int prow = t >> 6, pcol = t & 63;
        { float x[3][4]; float ss = 0.f;
#pragma unroll
          for (int j = 0; j < 3; ++j) { ld4(zr + ZC_BCQ + (lane + 64 * j) * 4, x[j]); ss += (x[j][0] * x[j][0] + x[j][1] * x[j][1]) + (x[j][2] * x[j][2] + x[j][3] * x[j][3]); }
          const float rstd = 1.0f / sqrtf(wave_sum(ss) * (1.0f / 768.0f) + EPS);
#pragma unroll
          for (int j = 0; j < 3; ++j) { const f32x4 g = *(const f32x4*)(P.in[I_BQN] + (size_t)l * 768 + (lane + 64 * j) * 4);
              float y[4] = {x[j][0] * rstd * g[0], x[j][1] * rstd * g[1], x[j][2] * rstd * g[2], x[j][3] * rstd * g[3]}; st4(zr + ZC_BCQ + (lane + 64 * j) * 4, y); } }
        { const u32x4 w = *(const u32x4*)(zr + ZC_BCKV + lane * 8);
          float x[8] = {bflo(w.x), bfhi(w.x), bflo(w.y), bfhi(w.y), bflo(w.z), bfhi(w.z), bflo(w.w), bfhi(w.w)}; float ss = 0.f;
#pragma unroll
          for (int e = 0; e < 8; ++e) ss += x[e] * x[e];
          const float rstd = 1.0f / sqrtf(wave_sum(ss) * (1.0f / 512.0f) + EPS);
          const f32x4 g0 = *(const f32x4*)(P.in[I_BKVN] + (size_t)l * 512 + lane * 8), g1 = *(const f32x4*)(P.in[I_BKVN] + (size_t)l * 512 + lane * 8 + 4);
          float y[8] = {x[0] * rstd * g0[0], x[1] * rstd * g0[1], x[2] * rstd * g0[2], x[3] * rstd * g0[3], x[4] * rstd * g1[0], x[5] * rstd * g1[1], x[6] * rstd * g1[2], x[7] * rstd * g1[3]};
          u32x4 o; o.x = pk2(y[0], y[1]); o.y = pk2(y[2], y[3]); o.z = pk2(y[4], y[5]); o.w = pk2(y[6], y[7]); *(u32x4*)(zr + ZC_BCKV + lane * 8) = o;
          if (!lat) { float* op = out + O_BCKV + po * 512 + lane * 8; *(f32x4*)op = (f32x4){y[0], y[1], y[2], y[3]}; *(f32x4*)(op + 4) = (f32x4){y[4], y[5], y[6], y[7]}; } }
        { const float x = bf2f(zr[ZC_BKPE + lane]);
          if (!lat) out[O_BKPE + po * 64 + lane] = x;
          else { const float xp = shx<16>(x); const int pos = lane < 32 ? prow : pcol, j = lane & 15; const float cs = tab[TB_C64 + pos * 16 + j], sn = tab[TB_S64 + pos * 16 + j];
              const float y = (lane & 16) ? x * cs + xp * sn : x * cs - xp * sn; zr[ZC_BKPE + lane] = (bf16_t)f2bf(y); } }
        { float x[16]; ld16(zr + ZC_CQ + lane * 16, x); float ss = 0.f;
#pragma unroll
          for (int e = 0; e < 16; ++e) ss += x[e] * x[e];
          ss += shx<1>(ss); ss += shx<2>(ss); ss += shx<4>(ss);
          const float rstd = 1.0f / sqrtf(ss * (1.0f / 128.0f) + EPS); const int lh = lane & 7;
#pragma unroll
          for (int e = 0; e < 16; ++e) x[e] = x[e] * rstd * P.in[I_CQN][l * 128 + lh * 16 + e];
          if (lat) { const int q = lh >> 1, pos = q < 2 ? prow : pcol, fb = (lh & 1) * 16; const bool second = q & 1;
#pragma unroll
              for (int e = 0; e < 16; ++e) { const float xp = shx<2>(x[e]); const float cs = tab[TB_C128 + pos * 32 + fb + e], sn = tab[TB_S128 + pos * 32 + fb + e];
                  x[e] = second ? x[e] * cs + xp * sn : x[e] * cs - xp * sn; } }
          st16(zr + ZC_CQ + lane * 16, x); }
        { float x[4]; ld4(zr + ZC_CK + lane * 4, x); float ss = (x[0] * x[0] + x[1] * x[1]) + (x[2] * x[2] + x[3] * x[3]);
          ss += shx<1>(ss); ss += shx<2>(ss); ss += shx<4>(ss); ss += shx<8>(ss); ss += shx<16>(ss);
          const float rstd = 1.0f / sqrtf(ss * (1.0f / 128.0f) + EPS); const int lh = lane & 31;
#pragma unroll
          for (int e = 0; e < 4; ++e) x[e] = x[e] * rstd * P.in[I_CKN][l * 128 + lh * 4 + e];
          if (!lat) *(f32x4*)(out + O_CK + po * 256 + lane * 4) = (f32x4){x[0], x[1], x[2], x[3]};
          else { const int q = lh >> 3, pos = q < 2 ? prow : pcol, fb = (lh & 7) * 4; const bool second = q & 1;
#pragma unroll
              for (int e = 0; e < 4; ++e) { const float xp = shx<8>(x[e]); const float cs = tab[TB_C128 + pos * 32 + fb + e], sn = tab[TB_S128 + pos * 32 + fb + e];
                  x[e] = second ? x[e] * cs + xp * sn : x[e] * cs - xp * sn; } }
          st4(zr + ZC_CK + lane * 4, x); }
        if (!lat) { float x[4]; ld4(zr + ZC_CV + lane * 4, x); *(f32x4*)(out + O_CV + po * 256 + lane * 4) = (f32x4){x[0], x[1], x[2], x[3]}; }
        {   const int lv = lane & 3, pos = lv < 2 ? prow : pcol; const bool second = lv & 1;
            if (lat) {
#pragma unroll
                for (int w = 0; w < 2; ++w) { bf16_t* p = zr + (w == 0 ? ZC_DQ : ZC_DK) + lane * 16; float x[16]; ld16(p, x);
#pragma unroll
                    for (int e = 0; e < 16; ++e) { const float xp = shx<1>(x[e]); const float cs = tab[TB_C64 + pos * 16 + e], sn = tab[TB_S64 + pos * 16 + e];
                        x[e] = second ? x[e] * cs + xp * sn : x[e] * cs - xp * sn; }
                    st16(p, x); }
            } else { float x[16]; ld16(zr + ZC_DK + lane * 16, x); st16f(out + O_DK + po * 1024 + lane * 16, x); } }
        if (!lat) { float x[16]; ld16(zr + ZC_DV + lane * 16, x); st16f(out + O_DV + po * 1024 + lane * 16, x);
            ld16(zr + ZC_AK + lane * 16, x); st16f(out + O_AK + po * 1024 + lane * 16, x);
            ld16(zr + ZC_AV + lane * 16, x); st16f(out + O_AV + po * 1024 + lane * 16, x); }
    }
}

__device__ __forceinline__ void ph_qbrope(const Params& P) {
    PH_IDS();
    bf16_t* QB = (bf16_t*)(P.ws + WS_QB); const float* tab = (const float*)(P.ws + WS_TAB);
    for (int i = gw; i < NL; i += NGW) {
        const int lb = i >> 11, t = i & 2047, r = NP + lb * LKV + t, prow = t >> 6, pcol = t & 63;
        const int hd = lane >> 3, lh = lane & 7, pos = lh < 4 ? prow : pcol, fb = (lh & 1) * 8; const bool second = lh & 2;
        bf16_t* p = QB + (size_t)r * LDQB + hd * 192 + 128 + lh * 8;
        const u32x4 w = *(const u32x4*)p; float x[8] = {bflo(w.x), bfhi(w.x), bflo(w.y), bfhi(w.y), bflo(w.z), bfhi(w.z), bflo(w.w), bfhi(w.w)};
#pragma unroll
        for (int e = 0; e < 8; ++e) { const float xp = shx<2>(x[e]); const float cs = tab[TB_C64 + pos * 16 + fb + e], sn = tab[TB_S64 + pos * 16 + fb + e];
            x[e] = second ? x[e] * cs + xp * sn : x[e] * cs - xp * sn; }
        u32x4 o; o.x = pk2(x[0], x[1]); o.y = pk2(x[2], x[3]); o.z = pk2(x[4], x[5]); o.w = pk2(x[6], x[7]); *(u32x4*)p = o;
    }
}

__device__ __forceinline__ void ph_merge(const Params& P, int l) {
    PH_IDS();
    const bf16_t* Z = (const bf16_t*)(P.ws + WS_Z); const bf16_t* OB = (const bf16_t*)(P.ws + WS_OB); bf16_t* Y = (bf16_t*)(P.ws + WS_Y);
    const float* tab = (const float*)(P.ws + WS_TAB); const float lam = tab[TB_LAM + 2 * l], omli = 1.0f - tab[TB_LAM + 2 * l + 1];
    for (int tok = gw; tok < NTOK; tok += NGW) {
        const bf16_t* zr = Z + (size_t)kvrow_of_tok(tok) * LDZ; const bf16_t* ob = OB + (size_t)tok * LDO; bf16_t* yr = Y + (size_t)tok * DM;
#pragma unroll
        for (int j = 0; j < 6; ++j) { const int col = (lane + 64 * j) * 8, grp = col >> 10, gc = (grp == 0 ? ZC_AZ : grp == 1 ? ZC_BZ : ZC_CZ) + (col & 1023);
            const u32x4 o = *(const u32x4*)(ob + col), g = *(const u32x4*)(zr + gc);
            u32x4 y; y.x = pk2(bflo(o.x) * silu_f(bflo(g.x)), bfhi(o.x) * silu_f(bfhi(g.x))); y.y = pk2(bflo(o.y) * silu_f(bflo(g.y)), bfhi(o.y) * silu_f(bfhi(g.y)));
            y.z = pk2(bflo(o.z) * silu_f(bflo(g.z)), bfhi(o.z) * silu_f(bfhi(g.z))); y.w = pk2(bflo(o.w) * silu_f(bflo(g.w)), bfhi(o.w) * silu_f(bfhi(g.w)));
            *(u32x4*)(yr + col) = y; }
        { const int hd = lane >> 3, lh = lane & 7; float o1[16], o2[16], gz[16];
          ld16(ob + 3072 + hd * 256 + lh * 16, o1); ld16(ob + 3072 + hd * 256 + 128 + lh * 16, o2); ld16(zr + ZC_DZ + hd * 128 + lh * 16, gz);
          float ss = 0.f;
#pragma unroll
          for (int e = 0; e < 16; ++e) { o1[e] = o1[e] - lam * o2[e]; ss += o1[e] * o1[e]; }
          ss += shx<1>(ss); ss += shx<2>(ss); ss += shx<4>(ss);
          const float rstd = 1.0f / sqrtf(ss * (1.0f / 128.0f) + EPS);
#pragma unroll
          for (int e = 0; e < 16; ++e) o1[e] = o1[e] * rstd * P.in[I_SUBLN][l * 128 + lh * 16 + e] * omli * silu_f(gz[e]);
          st16(yr + 3072 + hd * 128 + lh * 16, o1); }
    }
}

__device__ __forceinline__ void ph_final(const Params& P) {
    PH_IDS();
    const float* X = (const float*)(P.ws + WS_X); const float* g = P.in[I_FNG];
    for (int tok = gw; tok < NTOK; tok += NGW) {
        const float* xr = X + (size_t)tok * DM; f32x4 x[16]; float ss = 0.f;
#pragma unroll
        for (int j = 0; j < 16; ++j) { x[j] = *(const f32x4*)(xr + (j * 64 + lane) * 4); ss += (x[j][0] * x[j][0] + x[j][1] * x[j][1]) + (x[j][2] * x[j][2] + x[j][3] * x[j][3]); }
        const float rstd = 1.0f / sqrtf(wave_sum(ss) * (1.0f / DM) + EPS);
        float* orow = P.out + (size_t)tok * DM;
#pragma unroll
        for (int j = 0; j < 16; ++j) { const int c = (j * 64 + lane) * 4; *(f32x4*)(orow + c) = (x[j] * rstd) * *(const f32x4*)(g + c); }
    }
}

constexpr int N_PHASES = 18;
__global__ void __launch_bounds__(NTHR, 2) fwd_kernel(Params P) {
    extern __shared__ __attribute__((aligned(16))) unsigned char lds_raw[];
    LAS unsigned char* lds = (LAS unsigned char*)lds_raw;
    volatile LAS unsigned* MISC = (volatile LAS unsigned*)(lds + MISC_OFF);
    const int tid = threadIdx.x;
    const int G = gridDim.x;
    unsigned char* ws = P.ws;
    unsigned* ctl = (unsigned*)(ws + WS_CTL);
    if (tid < 32) MISC[tid] = 0u;
    __syncthreads();
    XcdBarrier bar; bar.bar = ctl + CW_BAR; bar.x = 0; bar.st = nullptr;
    if (MK_MODE == 0) bar = xcd_barrier_post(ctl + CW_BAR, MISC + 8);
    const int lo = P.ph_lo, hi = P.ph_hi;
#ifndef PH_MASK
#define PH_MASK 0x3ffffu
#endif
#define IN(k) (((PH_MASK >> (k)) & 1u) && lo <= (k) && (k) < hi)
#define SEAM(k) do { if (IN(k) && IN((k) + 1)) xcd_barrier(bar); } while (0)
    if (IN(0)) { ph_prologue(P, lds); }
    SEAM(0);
    for (int l = 0; l < DEPTH; ++l) {
        const int pb = 1 + 8 * l;
        if (IN(pb + 0)) ph_norm(P, l);
        SEAM(pb + 0);
        if (IN(pb + 1)) {
            pg8::Gemm g{(const bf16_t*)(ws + WS_H), (const bf16_t*)(ws + WS_BT1 + l * BT1_L), NTOK, LDZ, DM, DM, DM}; pg8::StaticOrder S; S.init(NTOK, LDZ, G, (int)blockIdx.x);
            pg8::EpiBf16 E{(bf16_t*)(ws + WS_Z), LDZ, 1};
            pg8::gemm_phase<pg8::EpiBf16, pg8::StaticOrder>(lds, g, S, E);
        }
        SEAM(pb + 1);
        if (IN(pb + 2)) ph_post(P, l);
        SEAM(pb + 2);
        if (IN(pb + 3)) {
            { pg8::Gemm g{(const bf16_t*)(ws + WS_Z) + ZC_BCQ, (const bf16_t*)(ws + WS_BUQ + l * BUQ_L), NKV, 1536, 768, LDZ, 768}; pg8::StaticOrder S; S.init(NKV, 1536, G, (int)blockIdx.x);
              pg8::EpiBf16 E{(bf16_t*)(ws + WS_QB), LDQB, 0};
              pg8::gemm_phase<pg8::EpiBf16, pg8::StaticOrder>(lds, g, S, E); }
            { pg8::Gemm g{(const bf16_t*)(ws + WS_Z) + ZC_BCKV, (const bf16_t*)(ws + WS_BUKV + l * BUKV_L), NKV, 2048, 512, LDZ, 512}; pg8::StaticOrder S; S.init(NKV, 2048, G, G - 1 - (int)blockIdx.x);
              pg8::EpiBf16 E{(bf16_t*)(ws + WS_KVB), LDKVB, 0};
              pg8::gemm_phase<pg8::EpiBf16, pg8::StaticOrder>(lds, g, S, E); }
        }
        SEAM(pb + 3);
        if (IN(pb + 4)) ph_qbrope(P);
        SEAM(pb + 4);
        if (IN(pb + 5)) {
#if !NAIVE_ATTN
            for (int rnd = 0; rnd < 2; ++rnd) {
#define ATT_SECT(sect, DKV, MSK) do { const int nu_ = attn_nunits(sect, rnd); unsigned* qc_ = ctl + CW_Q + 64 * ((l * 2 + rnd) * 4 + sect); \
                for (;;) { if (tid == 0) MISC[16] = atomicAdd(qc_, 1u); __syncthreads(); const int idx_ = (int)MISC[16]; __syncthreads(); if (idx_ >= nu_) break; \
                    const AttnUnit U = make_unit(sect, rnd, idx_, l, (bf16_t*)(ws + WS_Z), (bf16_t*)(ws + WS_QB), (bf16_t*)(ws + WS_KVB), (bf16_t*)(ws + WS_OB), P.in[I_RPB]); \
                    att::attn_body<DKV, MSK>(U, (char*)lds_raw); } } while (0)
#ifndef SECT_MASK
#define SECT_MASK 15
#endif
                if (SECT_MASK & 1) ATT_SECT(0, 192, false);
                if (SECT_MASK & 2) ATT_SECT(1, 128, false);
                if (SECT_MASK & 4) ATT_SECT(2, 64, false);
                if ((SECT_MASK & 8) && rnd == 0) ATT_SECT(3, 128, true);
#undef ATT_SECT
            }
#endif
        }
        SEAM(pb + 5);
        if (IN(pb + 6)) ph_merge(P, l);
        SEAM(pb + 6);
        if (IN(pb + 7)) {
            pg8::Gemm g{(const bf16_t*)(ws + WS_Y), (const bf16_t*)(ws + WS_BT2 + l * BT2_L), NTOK, DM, DM, DM, DM}; pg8::StaticOrder S; S.init(NTOK, DM, G, (int)blockIdx.x);
            const float* xp = l == 0 ? P.in[I_XP] : (const float*)(ws + WS_X); const float* xl = l == 0 ? P.in[I_XS] : (const float*)(ws + WS_X) + (size_t)NP * DM;
            pg8::EpiRes E{xp, xl, (float*)(ws + WS_X), (const float*)(ws + WS_CTL + CTL_MOD) + (size_t)l * 5 * 12288 + 8192};
            pg8::gemm_phase<pg8::EpiRes, pg8::StaticOrder>(lds, g, S, E);
        }
        SEAM(pb + 7);
    }
    if (IN(17)) ph_final(P);
#undef IN
#undef SEAM
}

#if NAIVE_ATTN
__global__ void __launch_bounds__(NTHR) naive_attn_kernel(Params P, int l, int sect, int rnd) {
    extern __shared__ __attribute__((aligned(16))) unsigned char lds_raw[];
    LAS float* sc_all = (LAS float*)lds_raw; LAS float* q_all = sc_all + 8 * 2304;
    unsigned char* ws = P.ws;
    const AttnUnit U = make_unit(sect, rnd, (int)blockIdx.x, l, (bf16_t*)(ws + WS_Z), (bf16_t*)(ws + WS_QB), (bf16_t*)(ws + WS_KVB), (bf16_t*)(ws + WS_OB), P.in[I_RPB]);
    naive_unit(U, sect == 0 ? 192 : sect == 2 ? 64 : 128, sc_all, q_all);
}
#endif

extern "C" void kernel_launch(void* const* d_in, const int* in_sizes, int n_in, void* d_out, int out_size, void* d_ws, size_t ws_size, hipStream_t stream) {
    static int grid = 0;
    if (grid == 0) {
        if (n_in != 30 || (size_t)out_size != O_END || ws_size < WS_END) { fprintf(stderr, "kernel_launch: shape mismatch: n_in %d out %d ws %zu (need %zu)\n", n_in, out_size, ws_size, (size_t)WS_END); grid = -1; return; }
        int dev = 0, cus = 0, per_cu = 0;
        if (hipGetDevice(&dev) != hipSuccess || hipDeviceGetAttribute(&cus, hipDeviceAttributeMultiprocessorCount, dev) != hipSuccess) { fprintf(stderr, "kernel_launch: device query failed\n"); grid = -1; return; }
        if (hipFuncSetAttribute((const void*)fwd_kernel, hipFuncAttributeMaxDynamicSharedMemorySize, LDS_BYTES) != hipSuccess) { fprintf(stderr, "kernel_launch: hipFuncSetAttribute failed\n"); grid = -1; return; }
#if NAIVE_ATTN
        if (hipFuncSetAttribute((const void*)naive_attn_kernel, hipFuncAttributeMaxDynamicSharedMemorySize, 81920) != hipSuccess) { fprintf(stderr, "kernel_launch: hipFuncSetAttribute (naive) failed\n"); grid = -1; return; }
#endif
        if (hipOccupancyMaxActiveBlocksPerMultiprocessor(&per_cu, (const void*)fwd_kernel, NTHR, LDS_BYTES) != hipSuccess || per_cu < 1)
            fprintf(stderr, "kernel_launch: note: occupancy query reports %d workgroups per CU\n", per_cu);
        (void)hipGetLastError();
        grid = cus;
    }
    if (grid < 0) return;
    if (hipMemsetAsync((char*)d_ws + WS_CTL, 0, CTL_BYTES, stream) != hipSuccess) { fprintf(stderr, "kernel_launch: memset failed\n"); return; }
    Params p{};
    for (int i = 0; i < 30; ++i) p.in[i] = (const float*)d_in[i];
    p.out = (float*)d_out; p.ws = (unsigned char*)d_ws;
#if MK_MODE == 0
    p.ph_lo = 0; p.ph_hi = N_PHASES;
    hipLaunchKernelGGL(fwd_kernel, dim3(grid), dim3(NTHR), LDS_BYTES, stream, p);
#else
    for (int ph = 0; ph < N_PHASES; ++ph) {
#if NAIVE_ATTN
        if (ph >= 1 && ph <= 16 && ((ph - 1) & 7) == 5) { const int l = (ph - 1) >> 3;
            for (int rnd = 0; rnd < 2; ++rnd) for (int sect = 0; sect < 4; ++sect) { const int nu = attn_nunits(sect, rnd); if (nu > 0) hipLaunchKernelGGL(naive_attn_kernel, dim3(nu), dim3(NTHR), 81920, stream, p, l, sect, rnd); }
            continue; }
#endif
        p.ph_lo = ph; p.ph_hi = ph + 1;
        hipLaunchKernelGGL(fwd_kernel, dim3(grid), dim3(NTHR), LDS_BYTES, stream, p);
    }
#endif
    const hipError_t le = hipPeekAtLastError();
    if (le != hipSuccess) fprintf(stderr, "kernel_launch: launch failed: %s\n", hipGetErrorName(le));
}
```

```cpp
#include <hip/hip_runtime.h>
#include <cstdio>
#include <cstdint>

#ifndef MK_MODE
#define MK_MODE 0
#endif
#ifndef PROBE_DUP
#define PROBE_DUP 0
#endif

#define LAS __attribute__((address_space(3)))
typedef unsigned short bf16_t;
typedef short bf16x8 __attribute__((ext_vector_type(8)));
typedef short s16x4 __attribute__((ext_vector_type(4)));
typedef float f32x4 __attribute__((ext_vector_type(4)));
typedef float f32x2 __attribute__((ext_vector_type(2)));
typedef float f32x16 __attribute__((ext_vector_type(16)));
typedef unsigned u32x4 __attribute__((ext_vector_type(4)));
typedef unsigned u32x2 __attribute__((ext_vector_type(2)));

constexpr int DM = 4096, NPB = 16, PSEQ = 256, NLB = 4, LSEQ = 2048, PAST = 256, DEPTH = 2;
constexpr int NP = NPB * PSEQ, NL = NLB * LSEQ, NTOK = NP + NL;
constexpr int LKV = LSEQ + PAST, NKV = NP + NLB * LKV;
constexpr int INC = 13120, LDZ = 13312;
constexpr float EPS = 1e-6f;
constexpr int ZC_AQ = 0, ZC_AK = 1024, ZC_AV = 2048, ZC_AZ = 3072, ZC_BCQ = 4096, ZC_BCKV = 4864, ZC_BZ = 5376, ZC_CQ = 6400, ZC_CK = 7424, ZC_CV = 7680,
              ZC_CZ = 7936, ZC_DQ = 8960, ZC_DK = 9984, ZC_DV = 11008, ZC_DZ = 12032, ZC_BKPE = 13056;
constexpr int LDQB = 1536, LDKVB = 2048, LDO = 5120;
constexpr size_t O_YP = 0, O_YS = 16777216, O_AK = 50331648, O_AV = 58720256, O_BCKV = 67108864, O_BKPE = 71303168, O_CK = 71827456, O_CV = 73924608,
                 O_DK = 76021760, O_DV = 84410368, O_END = 92798976;
constexpr size_t MiB = 1u << 20;
constexpr size_t WS_CTL = 0, CTL_BYTES = 1 * MiB;
constexpr int CW_BAR = 4096;
constexpr int CW_Q = 8192;
constexpr size_t CTL_MOD = 65536;
constexpr size_t WS_TAB = 1 * MiB;
constexpr size_t WS_BT1 = 2 * MiB, BT1_L = (size_t)LDZ * DM * 2;
constexpr size_t WS_BT2 = WS_BT1 + 2 * BT1_L, BT2_L = (size_t)DM * DM * 2;
constexpr size_t WS_BUQ = WS_BT2 + 2 * BT2_L, BUQ_L = (size_t)1536 * 768 * 2;
constexpr size_t WS_BUKV = WS_BUQ + 2 * BUQ_L, BUKV_L = (size_t)2048 * 512 * 2;
constexpr size_t WS_H = WS_BUKV + 2 * BUKV_L;
constexpr size_t WS_Z = WS_H + (size_t)NTOK * DM * 2;
constexpr size_t WS_QB = WS_Z + (size_t)NKV * LDZ * 2;
constexpr size_t WS_KVB = WS_QB + (size_t)NKV * LDQB * 2;
constexpr size_t WS_OB = WS_KVB + (size_t)NKV * LDKVB * 2;
constexpr size_t WS_Y = WS_OB + (size_t)NTOK * LDO * 2;
constexpr size_t WS_X = WS_Y + (size_t)NTOK * DM * 2;
constexpr size_t WS_END = WS_X + (size_t)NTOK * DM * 4;
static_assert(WS_BT1 % 256 == 0 && WS_BT2 % 256 == 0 && WS_BUQ % 256 == 0 && WS_BUKV % 256 == 0 && WS_H % 256 == 0 && WS_Z % 256 == 0 && WS_QB % 256 == 0 && WS_KVB % 256 == 0 &&
              WS_OB % 256 == 0 && WS_Y % 256 == 0 && WS_X % 256 == 0, "ws alignment");
constexpr int TB_C64 = 0, TB_S64 = 1024, TB_C128 = 2048, TB_S128 = 4096, TB_LAM = 6144;
constexpr int RING_BYTES = 131072, MISC_OFF = RING_BYTES + 320, LDS_BYTES = 147456;
constexpr int NWAVES = 8, NTHR = 512;

#define LDS_WAIT() asm volatile("s_waitcnt lgkmcnt(0)" ::: "memory")
#define VM_WAIT() asm volatile("s_waitcnt vmcnt(0)" ::: "memory")
__device__ __forceinline__ unsigned f2bf(float f) { unsigned u = __builtin_bit_cast(unsigned, f); return (u + 0x7fffu + ((u >> 16) & 1u)) >> 16; }
__device__ __forceinline__ unsigned pk2(float lo, float hi) { return f2bf(lo) | (f2bf(hi) << 16); }
__device__ __forceinline__ float bf2f(unsigned short b) { return __builtin_bit_cast(float, ((unsigned)b) << 16); }
__device__ __forceinline__ float bflo(unsigned w) { return __builtin_bit_cast(float, w << 16); }
__device__ __forceinline__ float bfhi(unsigned w) { return __builtin_bit_cast(float, w & 0xffff0000u); }
__device__ __forceinline__ unsigned cvt_pk_bf16(float lo, float hi) { unsigned r; asm volatile("v_cvt_pk_bf16_f32 %0, %1, %2" : "=v"(r) : "v"(lo), "v"(hi)); return r; }
template <int M> __device__ __forceinline__ float shx(float x) {
    if constexpr (M < 32) return __builtin_bit_cast(float, __builtin_amdgcn_ds_swizzle(__builtin_bit_cast(int, x), (M << 10) | 0x1f));
    else { auto rr = __builtin_amdgcn_permlane32_swap(__builtin_bit_cast(unsigned, x), __builtin_bit_cast(unsigned, x), false, false);
           return __builtin_bit_cast(float, (unsigned)rr[0]) == x ? __builtin_bit_cast(float, (unsigned)rr[1]) : __builtin_bit_cast(float, (unsigned)rr[0]); }
}
__device__ __forceinline__ float wave_sum(float v) {
    v += shx<1>(v); v += shx<2>(v); v += shx<4>(v); v += shx<8>(v); v += shx<16>(v);
    auto rr = __builtin_amdgcn_permlane32_swap(__builtin_bit_cast(unsigned, v), __builtin_bit_cast(unsigned, v), false, false);
    return __builtin_bit_cast(float, (unsigned)rr[0]) + __builtin_bit_cast(float, (unsigned)rr[1]);
}
__device__ __forceinline__ float wave_max(float v) {
    v = fmaxf(v, shx<1>(v)); v = fmaxf(v, shx<2>(v)); v = fmaxf(v, shx<4>(v)); v = fmaxf(v, shx<8>(v)); v = fmaxf(v, shx<16>(v));
    auto rr = __builtin_amdgcn_permlane32_swap(__builtin_bit_cast(unsigned, v), __builtin_bit_cast(unsigned, v), false, false);
    return fmaxf(__builtin_bit_cast(float, (unsigned)rr[0]), __builtin_bit_cast(float, (unsigned)rr[1]));
}
__device__ __forceinline__ float silu_f(float x) { return x / (1.0f + __expf(-x)); }
__device__ __forceinline__ int kvrow_of_tok(int tok) { if (tok < NP) return tok; const int r = tok - NP; return NP + (r >> 11) * LKV + (r & 2047); }

namespace pg8 {
constexpr int BM = 256, BK = 64, HALF = 128, HTB = HALF * BK * 2, STAGE_BYTES = 8 * HTB, NXCD = 8, WGM = 8;
__host__ __device__ __forceinline__ int lds_byte(int r, int c) { const int st = (r >> 4) * 2 + (c >> 5), rr = r & 15, cc = c & 31, ob = rr * 64 + cc * 2; return st * 1024 + (ob ^ (((ob >> 9) & 1) << 5)); }
__host__ __device__ __forceinline__ void stage_rc(int b, int& R, int& C) { const int st = b / 1024, sb = b % 1024, swz = sb ^ (((sb >> 9) & 1) << 5); R = (st >> 1) * 16 + swz / 64; C = (st & 1) * 32 + (swz % 64) / 2; }
__host__ __device__ __forceinline__ int perm32(int rho) { const int n = rho >> 4, i = rho & 15; return 8 * (i >> 2) + 4 * n + (i & 3); }

struct Unit { int pm, pn; };
struct Gemm { const bf16_t* A; const bf16_t* Bt; int M, N, K, lda, ldb; };

struct StaticOrder {
    int nM, nN, nwg, G, c;
    __host__ __device__ void init(int M, int N, int G_, int c_) { nM = M / BM; nN = N / BM; nwg = nM * nN; G = G_; c = c_; }
    __host__ __device__ bool next(int i, Unit& u) const {
        const long L = (long)i * G + c; if (L >= nwg) return false;
        int wgid = (int)L; { const int q = nwg / NXCD, r = nwg % NXCD, xcd = wgid % NXCD, off = wgid / NXCD; wgid = (xcd < r ? xcd * (q + 1) : r * (q + 1) + (xcd - r) * q) + off; }
        const int nig = WGM * nN, gid = wgid / nig, fm = gid * WGM, gsz = (nM - fm) < WGM ? (nM - fm) : WGM;
        u.pm = fm + ((wgid % nig) % gsz); u.pn = (wgid % nig) / gsz; return true;
    }
    __device__ __forceinline__ void a_ready(const Unit&) const {}
    __device__ __forceinline__ void done(const Unit&) const {}
};

struct EpiBf16 {
    static constexpr bool PERM = true;
    bf16_t* O; int ldc; int remap;
    __device__ __forceinline__ void operator()(const f32x4 (&acc)[2][2][4][2], const Unit& u, int wr, int wc, int fr, int fq) const {
        int pmo = u.pm; if (remap && pmo >= 16) { const int j = pmo - 16; pmo = 16 + (j >> 3) * 9 + (j & 7); }
        const int row0 = pmo * BM + wr * 64 + fr, col0 = u.pn * BM + wc * 32 + 8 * fq;
#pragma unroll
        for (int ai = 0; ai < 2; ++ai)
#pragma unroll
            for (int m = 0; m < 4; ++m) { bf16_t* rowp = O + (size_t)(row0 + ai * HALF + m * 16) * ldc + col0;
#pragma unroll
                for (int bj = 0; bj < 2; ++bj) { const f32x4 v0 = acc[ai][bj][m][0], v1 = acc[ai][bj][m][1];
                    u32x4 w; w.x = cvt_pk_bf16(v0[0], v0[1]); w.y = cvt_pk_bf16(v0[2], v0[3]); w.z = cvt_pk_bf16(v1[0], v1[1]); w.w = cvt_pk_bf16(v1[2], v1[3]);
                    *(u32x4*)(rowp + bj * HALF) = w; } }
    }
};
struct EpiRes {
    static constexpr bool PERM = false;
    const float* xinP; const float* xinL; float* xout; const float* gate;
    __device__ __forceinline__ void operator()(const f32x4 (&acc)[2][2][4][2], const Unit& u, int wr, int wc, int fr, int fq) const {
        const int row0 = u.pm * BM + wr * 64 + fr, col0 = u.pn * BM + wc * 32 + 4 * fq;
        const int v = u.pm < 16 ? 0 : 1 + ((u.pm - 16) >> 3);
        const float* gv = gate + (size_t)v * 12288 + col0;
        const float* xb = u.pm < 16 ? xinP + (size_t)row0 * DM : xinL + (size_t)(row0 - NP) * DM;
        f32x4 g4[2][2];
#pragma unroll
        for (int bj = 0; bj < 2; ++bj)
#pragma unroll
            for (int n = 0; n < 2; ++n) g4[bj][n] = *(const f32x4*)(gv + bj * HALF + n * 16);
#pragma unroll
        for (int ai = 0; ai < 2; ++ai)
#pragma unroll
            for (int m = 0; m < 4; ++m) { const size_t ro = (size_t)(ai * HALF + m * 16) * DM + col0; float* op = xout + (size_t)row0 * DM + ro; const float* ip = xb + ro;
#pragma unroll
                for (int bj = 0; bj < 2; ++bj)
#pragma unroll
                    for (int n = 0; n < 2; ++n) { const f32x4 x4 = *(const f32x4*)(ip + bj * HALF + n * 16); *(f32x4*)(op + bj * HALF + n * 16) = x4 + g4[bj][n] * acc[ai][bj][m][n]; } }
    }
};

#ifndef PG8_SP2
#define PG8_SP2 true
#endif
#ifndef PG8_ALIGN
#define PG8_ALIGN true
#endif
template <class Epi, class Sched, bool ALIGN_EPI = PG8_ALIGN, bool SP2 = PG8_SP2>
__device__ __forceinline__ void gemm_phase(LAS unsigned char* lds, const Gemm g, const Sched& S, const Epi& E) {
    int tid_ = threadIdx.x; asm volatile("" : "+v"(tid_));
    const int tid = tid_, wid = __builtin_amdgcn_readfirstlane(tid >> 6), lane = tid & 63, wr = wid >> 2, wc = wid & 3, fr = lane & 15, fq = lane >> 4;
    const int K = g.K, nt = K / BK;
    unsigned voffA[2], voffB[2];
#pragma unroll
    for (int i = 0; i < 2; ++i) { int R, C; stage_rc(tid * 16 + i * 8192, R, C); const int Rb = Epi::PERM ? ((R & ~31) + perm32(R & 31)) : R;
        voffA[i] = (unsigned)(R * g.lda + C) * 2u; voffB[i] = (unsigned)(Rb * g.ldb + C) * 2u; }
    const size_t kstep = (size_t)(BK * 2);
    const size_t hstepA = (size_t)HALF * g.lda * 2, hstepB = (size_t)HALF * g.ldb * 2;
    const size_t tstepA = 2 * hstepA, tstepB = 2 * hstepB;
    const unsigned ldsw = (unsigned)wid * 1024u;
    const int aoff = lds_byte(wr * 64 + fr, fq * 8), boff = lds_byte(wc * 32 + fr, fq * 8);
#define PG8_SA(b, h) (((b) * 2 + (h)) * HTB)
#define PG8_SB(b, h) ((4 + (b) * 2 + (h)) * HTB)
#define PG8_STAGE(bufoff, gbase, voff) do { _Pragma("unroll") for (int _i = 0; _i < 2; ++_i) \
        __builtin_amdgcn_global_load_lds((const unsigned*)((const char*)(gbase) + (voff)[_i]), (LAS unsigned*)(lds + (bufoff) + ldsw + _i * 8192), 16, 0, 0); } while (0)
#define PG8_LDA(dst, b, h) do { _Pragma("unroll") for (int m = 0; m < 4; ++m) _Pragma("unroll") for (int k = 0; k < 2; ++k) dst[m][k] = *(const LAS bf16x8*)(lds + PG8_SA(b, h) + aoff + m * 2048 + k * 1024); } while (0)
#define PG8_LDB(dst, b, h) do { _Pragma("unroll") for (int n = 0; n < 2; ++n) _Pragma("unroll") for (int k = 0; k < 2; ++k) dst[n][k] = *(const LAS bf16x8*)(lds + PG8_SB(b, h) + boff + n * 2048 + k * 1024); } while (0)
#define PG8_MMA(ai, bj, At, Bt) do { __builtin_amdgcn_s_setprio(1); _Pragma("unroll") for (int m = 0; m < 4; ++m) _Pragma("unroll") for (int n = 0; n < 2; ++n) _Pragma("unroll") for (int k = 0; k < 2; ++k) \
        acc[ai][bj][m][n] = __builtin_amdgcn_mfma_f32_16x16x32_bf16(Bt[n][k], At[m][k], acc[ai][bj][m][n], 0, 0, 0); __builtin_amdgcn_s_setprio(0); } while (0)
#define PG8_WAIT_V(n) asm volatile("s_waitcnt vmcnt(" #n ")" ::: "memory")
#define PG8_WAIT_L(n) asm volatile("s_waitcnt lgkmcnt(" #n ")" ::: "memory")
#define PG8_BAR __builtin_amdgcn_s_barrier()
#define PG8_SCHED __builtin_amdgcn_sched_barrier(0)
    Unit cur, nxt; int ui = 0;
    if (!S.next(0, cur)) return;
    f32x4 acc[2][2][4][2];
#pragma unroll
    for (int a = 0; a < 2; ++a)
#pragma unroll
        for (int b = 0; b < 2; ++b)
#pragma unroll
            for (int m = 0; m < 4; ++m)
#pragma unroll
                for (int n = 0; n < 2; ++n) acc[a][b][m][n] = (f32x4){0.f, 0.f, 0.f, 0.f};
    bf16x8 At[4][2], B0[2][2], B1[2][2];
    const char* cA = (const char*)g.A + (size_t)cur.pm * tstepA; const char* cB = (const char*)g.Bt + (size_t)cur.pn * tstepB;
    S.a_ready(cur);
    if constexpr (SP2) {
        PG8_STAGE(PG8_SB(0, 0), cB, voffB); PG8_STAGE(PG8_SB(0, 1), cB + hstepB, voffB); PG8_STAGE(PG8_SA(0, 0), cA, voffA); PG8_STAGE(PG8_SA(0, 1), cA + hstepA, voffA);
        if (wr == 1) PG8_BAR;
        PG8_WAIT_V(2); PG8_BAR;
        PG8_STAGE(PG8_SB(1, 0), cB + kstep, voffB); PG8_STAGE(PG8_SA(1, 0), cA + kstep, voffA); PG8_STAGE(PG8_SB(1, 1), cB + hstepB + kstep, voffB);
        PG8_WAIT_V(6); PG8_BAR;
    } else {
    PG8_STAGE(PG8_SB(0, 0), cB, voffB); PG8_STAGE(PG8_SA(0, 0), cA, voffA); PG8_STAGE(PG8_SB(0, 1), cB + hstepB, voffB); PG8_STAGE(PG8_SA(0, 1), cA + hstepA, voffA);
    if (wr == 1) PG8_BAR;
    PG8_WAIT_V(4); PG8_BAR;
    PG8_STAGE(PG8_SB(1, 0), cB + kstep, voffB); PG8_STAGE(PG8_SA(1, 0), cA + kstep, voffA); PG8_STAGE(PG8_SB(1, 1), cB + hstepB + kstep, voffB);
    PG8_WAIT_V(6); PG8_BAR;
    }
    for (;;) {
        const bool has_next = S.next(ui + 1, nxt);
        const char* nA = has_next ? (const char*)g.A + (size_t)nxt.pm * tstepA : cA; const char* nB = has_next ? (const char*)g.Bt + (size_t)nxt.pn * tstepB : cB;
        for (int t = 0; t < nt; t += 2) {
            const bool last = (t == nt - 2);
            const char* a1 = cA + (size_t)(t + 1) * kstep;
            const char* a2 = last ? nA : cA + (size_t)(t + 2) * kstep; const char* b2 = last ? nB : cB + (size_t)(t + 2) * kstep;
            const char* a3 = a2 + kstep; const char* b3 = b2 + kstep;
            if (last && has_next) S.a_ready(nxt);
            if constexpr (SP2) {
            PG8_LDB(B0, 0, 0); PG8_LDB(B1, 0, 1); PG8_SCHED; PG8_LDA(At, 0, 0); PG8_STAGE(PG8_SA(1, 1), a1 + hstepA, voffA);
            PG8_WAIT_V(8); PG8_WAIT_L(0); PG8_BAR; PG8_MMA(0, 0, At, B0); PG8_MMA(0, 1, At, B1); PG8_BAR; PG8_SCHED;
            PG8_LDA(At, 0, 1); PG8_STAGE(PG8_SB(0, 0), b2, voffB); PG8_STAGE(PG8_SB(0, 1), b2 + hstepB, voffB); PG8_STAGE(PG8_SA(0, 0), a2, voffA);
            PG8_WAIT_V(8); PG8_WAIT_L(0); PG8_BAR; PG8_MMA(1, 0, At, B0); PG8_MMA(1, 1, At, B1); PG8_BAR; PG8_SCHED;
            PG8_LDB(B0, 1, 0); PG8_LDB(B1, 1, 1); PG8_SCHED; PG8_LDA(At, 1, 0); PG8_STAGE(PG8_SA(0, 1), a2 + hstepA, voffA);
            PG8_WAIT_V(8); PG8_WAIT_L(0); PG8_BAR; PG8_MMA(0, 0, At, B0); PG8_MMA(0, 1, At, B1); PG8_BAR; PG8_SCHED;
            PG8_LDA(At, 1, 1); PG8_STAGE(PG8_SB(1, 0), b3, voffB); PG8_STAGE(PG8_SB(1, 1), b3 + hstepB, voffB); PG8_STAGE(PG8_SA(1, 0), a3, voffA);
            PG8_WAIT_V(8); PG8_WAIT_L(0); PG8_BAR; PG8_MMA(1, 0, At, B0); PG8_MMA(1, 1, At, B1); PG8_BAR; PG8_SCHED;
            } else {
            PG8_LDB(B0, 0, 0); PG8_SCHED; PG8_LDA(At, 0, 0); PG8_STAGE(PG8_SA(1, 1), a1 + hstepA, voffA);
            PG8_WAIT_L(8); PG8_BAR; PG8_WAIT_L(0); PG8_MMA(0, 0, At, B0); PG8_BAR; PG8_SCHED;
            PG8_LDB(B1, 0, 1); PG8_STAGE(PG8_SB(0, 0), b2, voffB);
            PG8_BAR; PG8_WAIT_L(0); PG8_MMA(0, 1, At, B1); PG8_BAR;
            PG8_LDA(At, 0, 1); PG8_STAGE(PG8_SA(0, 0), a2, voffA);
            PG8_BAR; PG8_WAIT_L(0); PG8_MMA(1, 0, At, B0); PG8_BAR; PG8_SCHED;
            PG8_STAGE(PG8_SB(0, 1), b2 + hstepB, voffB);
            PG8_WAIT_V(6); PG8_BAR; PG8_MMA(1, 1, At, B1); PG8_BAR;
            PG8_LDB(B0, 1, 0); PG8_SCHED; PG8_LDA(At, 1, 0); PG8_STAGE(PG8_SA(0, 1), a2 + hstepA, voffA);
            PG8_WAIT_L(8); PG8_BAR; PG8_WAIT_L(0); PG8_MMA(0, 0, At, B0); PG8_BAR; PG8_SCHED;
            PG8_LDB(B1, 1, 1); PG8_STAGE(PG8_SB(1, 0), b3, voffB);
            PG8_BAR; PG8_WAIT_L(0); PG8_MMA(0, 1, At, B1); PG8_BAR;
            PG8_LDA(At, 1, 1); PG8_STAGE(PG8_SA(1, 0), a3, voffA);
            PG8_BAR; PG8_WAIT_L(0); PG8_MMA(1, 0, At, B0); PG8_BAR; PG8_SCHED;
            PG8_STAGE(PG8_SB(1, 1), b3 + hstepB, voffB);
            PG8_WAIT_V(6); PG8_BAR; PG8_MMA(1, 1, At, B1); PG8_BAR;
            }
        }
        if constexpr (ALIGN_EPI) { if (wr == 0) PG8_BAR; }
        E(acc, cur, wr, wc, fr, fq); S.done(cur);
        if (!has_next) break;
#pragma unroll
        for (int a = 0; a < 2; ++a)
#pragma unroll
            for (int b = 0; b < 2; ++b)
#pragma unroll
                for (int m = 0; m < 4; ++m)
#pragma unroll
                    for (int n = 0; n < 2; ++n) acc[a][b][m][n] = (f32x4){0.f, 0.f, 0.f, 0.f};
        cur = nxt; cA = nA; cB = nB; ++ui;
        if constexpr (ALIGN_EPI) { if (wr == 1) PG8_BAR; }
    }
    PG8_WAIT_V(0);
    if constexpr (!ALIGN_EPI) { if (wr == 0) PG8_BAR; }
    PG8_BAR;
#undef PG8_SA
#undef PG8_SB
#undef PG8_STAGE
#undef PG8_LDA
#undef PG8_LDB
#undef PG8_MMA
#undef PG8_WAIT_V
#undef PG8_WAIT_L
#undef PG8_BAR
#undef PG8_SCHED
}
}

struct AttnUnit {
    const bf16_t* Q; int ldq;
    const bf16_t* K; int ldk;
    const bf16_t* Kpe;
    const bf16_t* V; int ldv;
    const bf16_t* G;
    bf16_t* Y;
    int nt, ntreal, nfirst, base1, base2;
    float scale;
    int tq0;
    int ropeq;
    const float* rpb;
    const float* tab;
    const float* subln;
    float lam, omli;
};

__host__ __device__ __forceinline__ int attn_nunits(int sect, int rnd) {
    if (rnd == 0) return sect == 2 ? 512 : 256;
    return sect == 0 ? 128 : sect == 1 ? 256 : sect == 2 ? 256 : 0;
}
__device__ __forceinline__ AttnUnit make_unit(int sect, int rnd, int idx, int l, bf16_t* z, bf16_t* qb, bf16_t* kvb, bf16_t* y, const float* a_rpb, const float* tab, const float* subln) {
    AttnUnit U; U.Kpe = nullptr; U.tq0 = 0; U.ropeq = 0; U.rpb = nullptr; U.tab = tab; U.subln = subln + l * 128; U.lam = tab[TB_LAM + 2 * l]; U.omli = 1.0f - tab[TB_LAM + 2 * l + 1];
    int tok0, kq0, kk0, h, grp, nkeys; bool masked = false;
    if (rnd == 0) {
        int lb, qoff;
        if (sect == 2) { const int q16 = idx & 15; h = (idx >> 4) & 7; lb = idx >> 7; qoff = q16 * 128; } else { const int qblk = idx & 7; h = (idx >> 3) & 7; lb = idx >> 6; qoff = qblk * 256; }
        tok0 = NP + lb * LSEQ + qoff; kk0 = NP + lb * LKV; kq0 = kk0 + qoff; nkeys = LKV; U.tq0 = qoff;
        grp = sect == 0 ? 1 : sect == 1 ? 2 : sect == 2 ? 3 : 0;
        if (sect == 0) U.ropeq = 1;
        if (sect == 3) { masked = true; U.rpb = a_rpb + (size_t)(l * 8 + h) * 465; }
    } else {
        int pb, qoff = 0;
        if (sect == 2) { qoff = (idx & 1) * 128; h = (idx >> 1) & 7; pb = idx >> 4; grp = 3; }
        else if (sect == 0) { h = idx & 7; pb = idx >> 3; grp = 1; }
        else { const int i2 = idx & 127; h = i2 & 7; pb = i2 >> 3; grp = idx < 128 ? 2 : 0; }
        kk0 = pb * 256; tok0 = kk0 + qoff; kq0 = tok0; nkeys = PSEQ;
    }
    const bf16_t* zq = z + (size_t)kq0 * LDZ; const bf16_t* zk = z + (size_t)kk0 * LDZ; bf16_t* yq = y + (size_t)tok0 * DM;
    if (grp == 0) { U.Q = zq + ZC_AQ + h * 128; U.ldq = LDZ; U.K = zk + ZC_AK + h * 128; U.ldk = LDZ; U.V = zk + ZC_AV + h * 128; U.ldv = LDZ; U.scale = 0.08838834764831845f; U.G = zq + ZC_AZ + h * 128; U.Y = yq + h * 128; }
    else if (grp == 1) { U.Q = qb + (size_t)kq0 * LDQB + h * 192; U.ldq = LDQB; U.K = kvb + (size_t)kk0 * LDKVB + h * 256; U.ldk = LDKVB; U.Kpe = zk + ZC_BKPE; U.V = kvb + (size_t)kk0 * LDKVB + h * 256 + 128; U.ldv = LDKVB;
        U.scale = 0.07216878364870323f; U.G = zq + ZC_BZ + h * 128; U.Y = yq + 1024 + h * 128; }
    else if (grp == 2) { U.Q = zq + ZC_CQ + h * 128; U.ldq = LDZ; U.K = zk + ZC_CK + (h >> 2) * 128; U.ldk = LDZ; U.V = zk + ZC_CV + (h >> 2) * 128; U.ldv = LDZ; U.scale = 0.08838834764831845f; U.G = zq + ZC_CZ + h * 128; U.Y = yq + 2048 + h * 128; }
    else { U.Q = zq + ZC_DQ + h * 128; U.ldq = LDZ; U.K = zk + ZC_DK + h * 128; U.ldk = LDZ; U.V = zk + ZC_DV + h * 128; U.ldv = LDZ; U.scale = 0.125f; U.G = zq + ZC_DZ + h * 128; U.Y = yq + 3072 + h * 128; }
    if (masked) {
        const int r0 = U.tq0 >> 6; int lo = r0 - 4; lo = lo < 0 ? 0 : (lo > 24 ? 24 : lo); int hs = r0 + 3 - 4; hs = hs < 0 ? 0 : (hs > 24 ? 24 : hs); const int hiR = hs + 7;
        U.ntreal = 4 + (hiR - lo + 1); U.nt = (U.ntreal + 1) & ~1; U.nfirst = 4; U.base1 = 32; U.base2 = lo;
    } else { U.nt = nkeys / 64; U.ntreal = U.nt; U.nfirst = U.nt; U.base1 = 0; U.base2 = 0; }
    return U;
}

namespace att {
constexpr float THR = 8.f;
#define SBAR() __builtin_amdgcn_sched_barrier(0)
__device__ __forceinline__ int crow(int r, int hi) { return (r & 3) + 8 * (r >> 2) + 4 * hi; }
__device__ __forceinline__ void partialSM(f32x16& p0, f32x16& p1, float& m_reg, float& mn, float& alpha, float C, float thr_raw) {
    float pmax = p0[0];
#pragma unroll
    for (int r = 1; r < 16; ++r) pmax = fmaxf(pmax, p0[r]);
#pragma unroll
    for (int r = 0; r < 16; ++r) pmax = fmaxf(pmax, p1[r]);
    { auto rr = __builtin_amdgcn_permlane32_swap(__float_as_uint(pmax), __float_as_uint(pmax), false, false);
      pmax = fmaxf(__uint_as_float(rr[0]), __uint_as_float(rr[1])); }
    if (__builtin_expect(__all(pmax - m_reg <= thr_raw), 1)) { mn = m_reg; alpha = 1.f; }
    else { mn = fmaxf(m_reg, pmax); alpha = __builtin_amdgcn_exp2f((m_reg - mn) * C); m_reg = mn; }
    const float mnC = -mn * C;
#pragma unroll
    for (int r = 0; r < 16; ++r) p0[r] = fmaf(p0[r], C, mnC);
#pragma unroll
    for (int r = 0; r < 16; ++r) p1[r] = fmaf(p1[r], C, mnC);
#pragma unroll
    for (int r = 0; r < 16; ++r) p0[r] = __builtin_amdgcn_exp2f(p0[r]);
}
__device__ __forceinline__ void finishSM(f32x16& p0, f32x16& p1, float alpha, float& l_reg, bf16x8& pa0, bf16x8& pa1, bf16x8& pa2, bf16x8& pa3) {
#pragma unroll
    for (int r = 0; r < 16; ++r) p1[r] = __builtin_amdgcn_exp2f(p1[r]);
    float ps = 0;
#pragma unroll
    for (int r = 0; r < 16; ++r) ps += p0[r];
#pragma unroll
    for (int r = 0; r < 16; ++r) ps += p1[r];
    { auto rr = __builtin_amdgcn_permlane32_swap(__float_as_uint(ps), __float_as_uint(ps), false, false);
      ps = __uint_as_float(rr[0]) + __uint_as_float(rr[1]); }
    l_reg = l_reg * alpha + ps;
#define PK4(P, BASE, OUT) do { unsigned a0 = cvt_pk_bf16(P[BASE + 0], P[BASE + 1]), a1 = cvt_pk_bf16(P[BASE + 2], P[BASE + 3]);   \
    unsigned b0 = cvt_pk_bf16(P[BASE + 4], P[BASE + 5]), b1 = cvt_pk_bf16(P[BASE + 6], P[BASE + 7]);                              \
    auto r0 = __builtin_amdgcn_permlane32_swap(a0, b0, false, false); auto r1 = __builtin_amdgcn_permlane32_swap(a1, b1, false, false); \
    u32x4 w = {r0[0], r1[0], r0[1], r1[1]}; OUT = *reinterpret_cast<bf16x8*>(&w); } while (0)
    PK4(p0, 0, pa0); PK4(p0, 8, pa1); PK4(p1, 0, pa2); PK4(p1, 8, pa3);
#undef PK4
}
template <int KW> __device__ __forceinline__ int kswz(int row, int colB) { return row * (KW * 2) + (colB ^ ((row & 7) << 4)); }
template <int DQ, int KW> __device__ __forceinline__ void qkt(f32x16& p0, f32x16& p1, const char* Ks, const bf16x8* qr, const char* qlds, int r32, int hi, int cofs) {
    p0 = f32x16{}; p1 = f32x16{};
#pragma unroll
    for (int d0 = 0; d0 < DQ / 16; ++d0) { const int cb = cofs + (d0 * 16 + hi * 8) * 2;
        const bf16x8 b0 = *reinterpret_cast<const bf16x8*>(Ks + kswz<KW>(r32, cb));
        const bf16x8 b1 = *reinterpret_cast<const bf16x8*>(Ks + kswz<KW>(32 + r32, cb));
        bf16x8 q; if (d0 < 8) q = qr[d0]; else q = *reinterpret_cast<const bf16x8*>(qlds + (d0 - 8) * 8192);
        p0 = __builtin_amdgcn_mfma_f32_32x32x16_bf16(b0, q, p0, 0, 0, 0);
        p1 = __builtin_amdgcn_mfma_f32_32x32x16_bf16(b1, q, p1, 0, 0, 0); }
}
__device__ __forceinline__ void rope_pair(bf16x8& a, bf16x8& b, const float* tc, const float* ts) {
    const f32x4 c0 = *(const f32x4*)tc, c1 = *(const f32x4*)(tc + 4), s0 = *(const f32x4*)ts, s1 = *(const f32x4*)(ts + 4);
    const float cs[8] = {c0[0], c0[1], c0[2], c0[3], c1[0], c1[1], c1[2], c1[3]}, sn[8] = {s0[0], s0[1], s0[2], s0[3], s1[0], s1[1], s1[2], s1[3]};
    u32x4 ua = *reinterpret_cast<u32x4*>(&a), ub = *reinterpret_cast<u32x4*>(&b), oa, ob;
#pragma unroll
    for (int w = 0; w < 4; ++w) { const float x1l = bflo(ua[w]), x1h = bfhi(ua[w]), x2l = bflo(ub[w]), x2h = bfhi(ub[w]);
        oa[w] = pk2(x1l * cs[2 * w] - x2l * sn[2 * w], x1h * cs[2 * w + 1] - x2h * sn[2 * w + 1]);
        ob[w] = pk2(x2l * cs[2 * w] + x1l * sn[2 * w], x2h * cs[2 * w + 1] + x1h * sn[2 * w + 1]); }
    a = *reinterpret_cast<bf16x8*>(&oa); b = *reinterpret_cast<bf16x8*>(&ob);
}
__device__ __forceinline__ int v_st(int k, int c) { const int kk = (k & ~0xC) | ((k & 4) << 1) | ((k & 8) >> 1); return ((kk >> 3) * 4 + (c >> 5)) * 512 + ((kk & 7) * 32 + (c & 31)) * 2; }
__device__ __forceinline__ int v_rd_base(int lane) { return ((lane & 3) << 3) | (((lane >> 2) & 3) << 6) | (((lane >> 4) & 1) << 5) | (((lane >> 5) & 1) << 8); }
constexpr int v_rd_off(int d0, int ks, int half) { return d0 * 512 + ks * 4096 + half * 2048; }
template <int OFF> __device__ __forceinline__ s16x4 tr_read(int vb) {
    s16x4 r; asm volatile("ds_read_b64_tr_b16 %0, %1 offset:%2" : "=&v"(r) : "v"(vb), "i"(OFF) : "memory"); return r;
}
template <int D0> __device__ __forceinline__ void pv_one(f32x16& od, int vb, bf16x8 pa0, bf16x8 pa1, bf16x8 pa2, bf16x8 pa3) {
    const s16x4 l0 = tr_read<v_rd_off(D0, 0, 0)>(vb), h0 = tr_read<v_rd_off(D0, 0, 1)>(vb), l1 = tr_read<v_rd_off(D0, 1, 0)>(vb), h1 = tr_read<v_rd_off(D0, 1, 1)>(vb);
    const s16x4 l2 = tr_read<v_rd_off(D0, 2, 0)>(vb), h2 = tr_read<v_rd_off(D0, 2, 1)>(vb), l3 = tr_read<v_rd_off(D0, 3, 0)>(vb), h3 = tr_read<v_rd_off(D0, 3, 1)>(vb);
    asm volatile("s_waitcnt lgkmcnt(0)" ::: "memory"); SBAR();
#define PK(L, H) (bf16x8){L[0], L[1], L[2], L[3], H[0], H[1], H[2], H[3]}
    od = __builtin_amdgcn_mfma_f32_32x32x16_bf16(pa0, PK(l0, h0), od, 0, 0, 0);
    od = __builtin_amdgcn_mfma_f32_32x32x16_bf16(pa1, PK(l1, h1), od, 0, 0, 0);
    od = __builtin_amdgcn_mfma_f32_32x32x16_bf16(pa2, PK(l2, h2), od, 0, 0, 0);
    od = __builtin_amdgcn_mfma_f32_32x32x16_bf16(pa3, PK(l3, h3), od, 0, 0, 0);
#undef PK
}
__device__ __forceinline__ void pv_d0(f32x16* o, int vb, bf16x8 pa0, bf16x8 pa1, bf16x8 pa2, bf16x8 pa3) {
    pv_one<0>(o[0], vb, pa0, pa1, pa2, pa3); pv_one<1>(o[1], vb, pa0, pa1, pa2, pa3); pv_one<2>(o[2], vb, pa0, pa1, pa2, pa3); pv_one<3>(o[3], vb, pa0, pa1, pa2, pa3);
}

template <int DQ, int KW, bool MASK, bool DPAIR>
__device__ __forceinline__ void attn_body(const AttnUnit& U, char* lds) {
    constexpr int SHM_V = 16384, SHM_K = 64 * KW * 2, ND0 = DQ / 16, NKC = KW / 64, CPR = KW / 8, SD = 1;
    int tid_ = threadIdx.x; asm volatile("" : "+v"(tid_));
    const int tid = tid_, wid = __builtin_amdgcn_readfirstlane(tid >> 6), lane = tid & 63, r32 = lane & 31, hi = lane >> 5;
    const int sub = DPAIR ? (wid >> 2) : 0, rowbase = DPAIR ? (wid & 3) * 32 : wid * 32, cofs = sub * 128;
    char* V_lds = lds; char* K_lds = lds + 2 * SHM_V;
    constexpr int WSF_OFF = 122880, RPB_OFF = WSF_OFF + 2048, QL_OFF = 2 * SHM_V + 2 * SHM_K;
    constexpr int GT_ROWB = 272, GT_OFF = DPAIR ? 65536 : 0, GCH = DPAIR ? 4 : 8;
    float* wsf = (float*)(lds + WSF_OFF) + wid * 64; float* li_l = wsf; float* al_l = wsf + 32;
    float* rpb_l = (float*)(lds + RPB_OFF);
    const float Cc = U.scale * 1.4426950408889634f, thr_raw = THR / U.scale;
    constexpr int NQR = ND0 < 8 ? ND0 : 8;
    const char* qlds = lds + QL_OFF + tid * 16;
    float m_reg = -1e30f, l_reg = 0; f32x16 o[4] = {}; bf16x8 qr[NQR];
    { const bf16_t* Qw = U.Q + (long)(rowbase + r32) * U.ldq + sub * 64 + hi * 8;
#pragma unroll
      for (int d0 = 0; d0 < NQR; ++d0) qr[d0] = *reinterpret_cast<const bf16x8*>(Qw + d0 * 16);
      if constexpr (DQ == 192) {
          bf16x8 q8 = *reinterpret_cast<const bf16x8*>(Qw + 128), q9 = *reinterpret_cast<const bf16x8*>(Qw + 144), q10 = *reinterpret_cast<const bf16x8*>(Qw + 160), q11 = *reinterpret_cast<const bf16x8*>(Qw + 176);
          if (U.ropeq) { const int t = U.tq0 + rowbase + r32, prow = t >> 6, pcol = t & 63;
              rope_pair(q8, q9, U.tab + TB_C64 + prow * 16 + hi * 8, U.tab + TB_S64 + prow * 16 + hi * 8);
              rope_pair(q10, q11, U.tab + TB_C64 + pcol * 16 + hi * 8, U.tab + TB_S64 + pcol * 16 + hi * 8); }
          char* qw = lds + QL_OFF + tid * 16;
          *(bf16x8*)(qw) = q8; *(bf16x8*)(qw + 8192) = q9; *(bf16x8*)(qw + 16384) = q10; *(bf16x8*)(qw + 24576) = q11; } }
    int qrw = 0, srw = 0, qc = 0; unsigned vm0 = 0, vm1 = 0;
    if constexpr (MASK) {
        qrw = (U.tq0 >> 6) + (wid >> 1); srw = qrw - 4; srw = srw < 0 ? 0 : (srw > 24 ? 24 : srw);
        qc = 32 * (wid & 1) + r32; int scq = qc - 8; scq = scq < 0 ? 0 : (scq > 48 ? 48 : scq);
#pragma unroll
        for (int r = 0; r < 16; ++r) { const int k0 = crow(r, hi), k1 = 32 + k0; vm0 |= (unsigned)(k0 >= scq && k0 < scq + 16) << r; vm1 |= (unsigned)(k1 >= scq && k1 < scq + 16) << r; }
        const float isc = 1.0f / U.scale;
        if (tid < 465) rpb_l[tid] = U.rpb[tid] * isc;
    }
    const int sr = tid >> 4, sc = (tid & 15) * 8, vst0 = v_st(sr, sc), vst1 = v_st(32 + sr, sc);
    const int vo0 = sr * U.ldv + sc, vo1 = (32 + sr) * U.ldv + sc, vts = 64 * U.ldv;
    int ko[NKC], kst[NKC]; bool kpe[NKC];
#pragma unroll
    for (int i = 0; i < NKC; ++i) { const int c = tid + i * 512, row = c / CPR, cc = c % CPR;
        kpe[i] = (KW == 192 && cc >= 16);
        ko[i] = kpe[i] ? row * LDZ + (cc - 16) * 8 : row * U.ldk + cc * 8;
        kst[i] = kswz<KW>(row, cc * 16); }
    const int ktsn = 64 * U.ldk, ktsp = 64 * LDZ;
    const int vb0 = (int)(uintptr_t)V_lds + v_rd_base(lane);
    struct Slot { bf16x8 vs0, vs1, ks[NKC]; } sl[SD];
#define KT_OF(j) ((j) < U.nfirst ? U.base1 + (j) : U.base2 + (j) - U.nfirst)
#define SLOAD(i, j) do { const int kt_ = KT_OF(j); sl[i].vs0 = *reinterpret_cast<const bf16x8*>(U.V + (vo0 + kt_ * vts)); sl[i].vs1 = *reinterpret_cast<const bf16x8*>(U.V + (vo1 + kt_ * vts)); \
    _Pragma("unroll") for (int c_ = 0; c_ < NKC; ++c_) sl[i].ks[c_] = kpe[c_] ? *reinterpret_cast<const bf16x8*>(U.Kpe + (ko[c_] + kt_ * ktsp)) : *reinterpret_cast<const bf16x8*>(U.K + (ko[c_] + kt_ * ktsn)); } while (0)
#define SWRITE(b, i) do { *(bf16x8*)(V_lds + (b) * SHM_V + vst0) = sl[i].vs0; *(bf16x8*)(V_lds + (b) * SHM_V + vst1) = sl[i].vs1; \
    _Pragma("unroll") for (int c_ = 0; c_ < NKC; ++c_) *(bf16x8*)(K_lds + (b) * SHM_K + kst[c_]) = sl[i].ks[c_]; } while (0)
#define SWAIT() do { if constexpr (SD == 1) asm volatile("s_waitcnt vmcnt(0)" ::: "memory"); else if constexpr (NKC == 1) asm volatile("s_waitcnt vmcnt(3)" ::: "memory"); else asm volatile("s_waitcnt vmcnt(4)" ::: "memory"); } while (0)
#define RESC(a) do { if (__any((a) < 1.f)) { if (hi == 0) al_l[r32] = (a); asm volatile("s_waitcnt lgkmcnt(0)" ::: "memory"); \
    _Pragma("unroll") for (int d = 0; d < 4; ++d) _Pragma("unroll") for (int r = 0; r < 16; ++r) o[d][r] *= al_l[crow(r, hi)]; } } while (0)
#define MASKB(P0, P1, j) do { if constexpr (MASK) { const int kt_ = KT_OF(j); \
    if ((j) >= U.ntreal || (kt_ < 32 && (kt_ < srw || kt_ > srw + 7))) { _Pragma("unroll") for (int r = 0; r < 16; ++r) { P0[r] = -1e30f; P1[r] = -1e30f; } } \
    else if (kt_ < 32) { const int bi_ = (kt_ - qrw + 7) * 31 + 15 - qc; \
        _Pragma("unroll") for (int r = 0; r < 16; ++r) { const int kc_ = crow(r, hi); const bool v0_ = (vm0 >> r) & 1u, v1_ = (vm1 >> r) & 1u; \
            const float b0_ = rpb_l[v0_ ? bi_ + kc_ : 0], b1_ = rpb_l[v1_ ? bi_ + kc_ + 32 : 0]; \
            P0[r] = v0_ ? P0[r] + b0_ : -1e30f; P1[r] = v1_ ? P1[r] + b1_ : -1e30f; } } } } while (0)
    f32x16 pA0, pA1, pB0, pB1; float mnA, mnB, alA, alB; bf16x8 pa0, pa1, pa2, pa3; const int NT = U.nt;
    constexpr int SE = 0, SO = SD - 1;
    SLOAD(SE, 0); asm volatile("s_waitcnt vmcnt(0)" ::: "memory"); SWRITE(0, SE); __syncthreads();
    qkt<DQ, KW>(pA0, pA1, K_lds, qr, qlds, r32, hi, cofs); MASKB(pA0, pA1, 0); partialSM(pA0, pA1, m_reg, mnA, alA, Cc, thr_raw);
    SLOAD(SO, 1); if constexpr (SD == 2) { if (2 < NT) SLOAD(SE, 2); }
    SWAIT(); SWRITE(1, SO); __syncthreads();
    for (int j = 1; j + 1 < NT; j += 2) {
        SBAR(); qkt<DQ, KW>(pB0, pB1, K_lds + SHM_K, qr, qlds, r32, hi, cofs);
        finishSM(pA0, pA1, alA, l_reg, pa0, pa1, pa2, pa3); SBAR();
        SLOAD(SO, j + SD); SBAR();
        pv_d0(o, vb0, pa0, pa1, pa2, pa3); MASKB(pB0, pB1, j); partialSM(pB0, pB1, m_reg, mnB, alB, Cc, thr_raw);
        __syncthreads(); SWAIT(); SWRITE(0, SE);
        RESC(alB); __syncthreads();
        SBAR(); qkt<DQ, KW>(pA0, pA1, K_lds, qr, qlds, r32, hi, cofs);
        finishSM(pB0, pB1, alB, l_reg, pa0, pa1, pa2, pa3); SBAR();
        if (SD == 1 || j + 3 < NT) SLOAD(SE, j + 1 + SD); SBAR();
        pv_d0(o, vb0 + SHM_V, pa0, pa1, pa2, pa3); MASKB(pA0, pA1, j + 1); partialSM(pA0, pA1, m_reg, mnA, alA, Cc, thr_raw);
        __syncthreads(); SWAIT(); SWRITE(1, SO);
        RESC(alA); __syncthreads();
    }
    const int g_off = (tid >> 4) * LDZ + (tid & 15) * 8, t_off = GT_OFF + (tid >> 4) * GT_ROWB + (tid & 15) * 16;
    bf16x8 gch[GCH];
#pragma unroll
    for (int i = 0; i < 4; ++i) gch[i] = *reinterpret_cast<const bf16x8*>(U.G + (g_off + i * 32 * LDZ));
    SBAR(); qkt<DQ, KW>(pB0, pB1, K_lds + SHM_K, qr, qlds, r32, hi, cofs);
    finishSM(pA0, pA1, alA, l_reg, pa0, pa1, pa2, pa3); SBAR();
    pv_d0(o, vb0, pa0, pa1, pa2, pa3); MASKB(pB0, pB1, NT - 1); partialSM(pB0, pB1, m_reg, mnB, alB, Cc, thr_raw);
    __syncthreads(); RESC(alB);
    finishSM(pB0, pB1, alB, l_reg, pa0, pa1, pa2, pa3); SBAR();
    pv_d0(o, vb0 + SHM_V, pa0, pa1, pa2, pa3);
#pragma unroll
    for (int i = 4; i < GCH; ++i) gch[i] = *reinterpret_cast<const bf16x8*>(U.G + (g_off + i * 32 * LDZ));
    if (hi == 0) li_l[r32] = l_reg; asm volatile("s_waitcnt lgkmcnt(0)" ::: "memory");
#pragma unroll
    for (int r = 0; r < 16; ++r) { const float rl = __builtin_amdgcn_rcpf(li_l[crow(r, hi)]);
#pragma unroll
        for (int d0 = 0; d0 < 4; ++d0) o[d0][r] *= rl; }
    __syncthreads();
    char* tl = lds + (rowbase * GT_ROWB + GT_OFF + r32 * 2);
    if constexpr (!DPAIR) {
#pragma unroll
        for (int i = 0; i < GCH; ++i) *(bf16x8*)(lds + t_off + i * 32 * GT_ROWB) = gch[i];
        __syncthreads();
#pragma unroll
        for (int r = 0; r < 16; ++r) { char* tr = tl + crow(r, hi) * GT_ROWB;
#pragma unroll
            for (int d0 = 0; d0 < 4; ++d0) { unsigned short* p = (unsigned short*)(tr + d0 * 64); const float g = bf2f(*p); *p = (unsigned short)f2bf(o[d0][r] * silu_f(g)); } }
    } else {
        float* xch = (float*)lds + ((wid & 3) * 64 + lane);
        if (sub == 1) {
#pragma unroll
            for (int d0 = 0; d0 < 4; ++d0)
#pragma unroll
                for (int r = 0; r < 16; ++r) xch[(d0 * 16 + r) * 256] = o[d0][r];
        }
#pragma unroll
        for (int i = 0; i < GCH; ++i) *(bf16x8*)(lds + t_off + i * 32 * GT_ROWB) = gch[i];
        __syncthreads();
        if (sub == 0) {
            const float lam = U.lam; float gl[4];
#pragma unroll
            for (int d0 = 0; d0 < 4; ++d0) gl[d0] = U.subln[d0 * 32 + r32] * U.omli;
#pragma unroll
            for (int r = 0; r < 16; ++r) { float ss = 0.f;
#pragma unroll
                for (int d0 = 0; d0 < 4; ++d0) { const float od = o[d0][r] - lam * xch[(d0 * 16 + r) * 256]; o[d0][r] = od; ss += od * od; }
                ss += shx<1>(ss); ss += shx<2>(ss); ss += shx<4>(ss); ss += shx<8>(ss); ss += shx<16>(ss);
                const float rstd = 1.0f / sqrtf(ss * (1.0f / 128.0f) + EPS); char* tr = tl + crow(r, hi) * GT_ROWB;
#pragma unroll
                for (int d0 = 0; d0 < 4; ++d0) { unsigned short* p = (unsigned short*)(tr + d0 * 64); const float g = bf2f(*p); *p = (unsigned short)f2bf(o[d0][r] * rstd * gl[d0] * silu_f(g)); } }
        }
    }
    __syncthreads();
    { bf16_t* yb = U.Y + ((tid >> 4) * DM + (tid & 15) * 8);
#pragma unroll
      for (int i = 0; i < GCH; ++i) *reinterpret_cast<bf16x8*>(yb + i * 32 * DM) = *(const bf16x8*)(lds + t_off + i * 32 * GT_ROWB); }
    __syncthreads();
#undef KT_OF
#undef SLOAD
#undef SWRITE
#undef SWAIT
#undef RESC
#undef MASKB
}
}

#define XB_TMO      128
#define XB_XCNT(j)  (256  + 64 * (j))
#define XB_XSUB(j)  (1280 + 64 * (j))
#define XB_XGEN(j)  (2304 + 64 * (j))
#define XB_TOP      3328
#define XB_TOPGEN   3392
#define XCD_BAR_WORDS 3456
#define XB_SPIN_CAP (1u << 22)
__device__ __forceinline__ unsigned xb_ld(unsigned* p)              { return __hip_atomic_load(p, __ATOMIC_RELAXED, __HIP_MEMORY_SCOPE_AGENT); }
__device__ __forceinline__ unsigned xb_add(unsigned* p, unsigned v) { return __hip_atomic_fetch_add(p, v, __ATOMIC_RELAXED, __HIP_MEMORY_SCOPE_AGENT); }
__device__ __forceinline__ unsigned xb_xcc_id() { return (unsigned)__builtin_amdgcn_s_getreg((3 << 11) | 20) & 0xFu; }
#define XB_SPIN(cond, bar) do { unsigned _sp = 0; while (cond) { __builtin_amdgcn_s_sleep(1); \
    if ((++_sp & 255u) == 0u) { if (xb_ld(&(bar)[XB_TMO])) break; if (_sp > XB_SPIN_CAP) { atomicAdd(&(bar)[XB_TMO], 1u); break; } } } } while (0)
struct XcdBarrier { unsigned* bar; unsigned x; volatile LAS unsigned* st; };
__device__ __forceinline__ XcdBarrier xcd_barrier_post(unsigned* bar, volatile LAS unsigned* st) {
    XcdBarrier b; b.bar = bar; b.x = xb_xcc_id(); b.st = st;
    if (threadIdx.x == 0) (void)xb_add(&bar[XB_XCNT(b.x)], 1u);
    return b;
}
__device__ __forceinline__ void xcd_barrier_complete(unsigned* bar, unsigned x, unsigned& nloc, unsigned& nx) {
    const unsigned G = gridDim.x * gridDim.y * gridDim.z;
    unsigned sum, cnt, mine, sp = 0u;
    for (;;) {
        sum = 0u; cnt = 0u; mine = 0u;
#pragma unroll
        for (unsigned j = 0; j < 16; ++j) { const unsigned c = xb_ld(&bar[XB_XCNT(j)]); sum += c; cnt += (c > 0u) ? 1u : 0u; mine = (j == x) ? c : mine; }
        if (sum == G) break;
        __builtin_amdgcn_s_sleep(1);
        if ((++sp & 255u) == 0u) { if (xb_ld(&bar[XB_TMO])) break; if (sp > XB_SPIN_CAP) { atomicAdd(&bar[XB_TMO], 1u); break; } }
    }
    nloc = mine > 0u ? mine : 1u; nx = cnt > 0u ? cnt : 1u;
}
__device__ __forceinline__ void xcd_barrier(const XcdBarrier& b) {
    asm volatile("s_waitcnt vmcnt(0)" ::: "memory");
    __syncthreads();
    if (threadIdx.x == 0) {
        unsigned* bar = b.bar;
        __builtin_amdgcn_s_waitcnt(0);
        unsigned nloc = b.st[0], nx = b.st[1];
        if (nloc == 0u) { xcd_barrier_complete(bar, b.x, nloc, nx); b.st[0] = nloc; b.st[1] = nx; }
        const unsigned old = xb_add(&bar[XB_XSUB(b.x)], 1u);
        const unsigned gen = old / nloc;
        if (old + 1u == (gen + 1u) * nloc) {
            __builtin_amdgcn_fence(__ATOMIC_RELEASE, "agent");
            asm volatile("s_waitcnt vmcnt(0)" ::: "memory");
            const unsigned og = xb_add(&bar[XB_TOP], 1u);
            const unsigned tg = og / nx;
            if (og + 1u == (tg + 1u) * nx) xb_add(&bar[XB_TOPGEN], 1u);
            else XB_SPIN(xb_ld(&bar[XB_TOPGEN]) == tg, bar);
            __builtin_amdgcn_fence(__ATOMIC_ACQUIRE, "agent");
            xb_add(&bar[XB_XGEN(b.x)], 1u);
            asm volatile("s_waitcnt vmcnt(0)" ::: "memory");
        } else {
            XB_SPIN(xb_ld(&bar[XB_XGEN(b.x)]) == gen, bar);
            __builtin_amdgcn_fence(__ATOMIC_ACQUIRE, "agent");
            asm volatile("s_waitcnt vmcnt(0)" ::: "memory");
        }
    }
    __syncthreads();
}

struct Params { const float* in[30]; float* out; unsigned char* ws; int ph_lo, ph_hi; };
enum { I_XP = 0, I_XS, I_CAK, I_CAV, I_CBCKV, I_CBKPE, I_CCK, I_CCV, I_CDK, I_CDV, I_C, I_CCTX, I_NORMG, I_WADA, I_BADA, I_WIN, I_WOUT, I_RPB, I_BQN, I_WUQ, I_BKVN, I_WUKV,
       I_CQN, I_CKN, I_LQ1, I_LK1, I_LQ2, I_LK2, I_SUBLN, I_FNG };

__device__ __forceinline__ void transpose_item(const float* __restrict__ W, int ldw, int k0, int nsrc0, bf16_t* __restrict__ WT, int K, int ndst0, LAS unsigned* scr, int lane) {
    const int kk = lane >> 4, n4 = (lane & 15) * 4;
    const float* src = W + (size_t)(k0 + 2 * kk) * ldw + nsrc0 + n4;
    f32x4 a[8], b[8];
#pragma unroll
    for (int i = 0; i < 8; ++i) { a[i] = *(const f32x4*)(src + (size_t)(8 * i) * ldw); b[i] = *(const f32x4*)(src + (size_t)(8 * i + 1) * ldw); }
#pragma unroll
    for (int i = 0; i < 8; ++i) { u32x4 w; w.x = pk2(a[i][0], b[i][0]); w.y = pk2(a[i][1], b[i][1]); w.z = pk2(a[i][2], b[i][2]); w.w = pk2(a[i][3], b[i][3]);
        *(LAS u32x4*)(scr + (i * 4 + kk) * 68 + n4) = w; }
    LDS_WAIT(); asm volatile("" ::: "memory");
    const int kp4 = (lane & 7) * 4;
#pragma unroll
    for (int j = 0; j < 8; ++j) { const int n = (lane >> 3) + 8 * j; const LAS unsigned* sp = scr + kp4 * 68 + n;
        u32x4 o; o.x = sp[0]; o.y = sp[68]; o.z = sp[136]; o.w = sp[204];
        *(u32x4*)(WT + (size_t)(ndst0 + n) * K + k0 + kp4 * 2) = o; }
    LDS_WAIT(); asm volatile("" ::: "memory");
}

#define PH_WS() unsigned char* ws = P.ws; asm volatile("" : "+s"(ws))
#define PH_IDS() int tid_ = threadIdx.x; asm volatile("" : "+v"(tid_)); const int lane = tid_ & 63, wave = __builtin_amdgcn_readfirstlane(tid_ >> 6), NGW = gridDim.x * NWAVES, gw = blockIdx.x * NWAVES + wave; (void)wave
__device__ __forceinline__ void ph_prologue(const Params& P, LAS unsigned char* lds, bool gemv) {
    PH_IDS(); PH_WS();
    if (gemv) for (int it = gw; it < 2048; it += NGW) {
        const int l = it >> 10, dch = (it >> 4) & 63, cb = it & 15;
        const float* W = P.in[I_WADA] + (size_t)l * DM * 12288 + (size_t)(dch * 64) * 12288 + cb * 768 + lane * 4;
        f32x4 acc[5][3];
#pragma unroll
        for (int v = 0; v < 5; ++v)
#pragma unroll
            for (int j = 0; j < 3; ++j) acc[v][j] = (f32x4){0.f, 0.f, 0.f, 0.f};
#pragma unroll 4
        for (int r = 0; r < 64; ++r) {
            const int d = dch * 64 + r;
            float s[5]; s[0] = silu_f(P.in[I_CCTX][d]);
#pragma unroll
            for (int v = 1; v < 5; ++v) s[v] = silu_f(P.in[I_C][(v - 1) * DM + d]);
            f32x4 w[3];
#pragma unroll
            for (int j = 0; j < 3; ++j) w[j] = *(const f32x4*)(W + (size_t)r * 12288 + j * 256);
#pragma unroll
            for (int v = 0; v < 5; ++v)
#pragma unroll
                for (int j = 0; j < 3; ++j) acc[v][j] += w[j] * s[v];
        }
        float* mod = (float*)(ws + WS_CTL + CTL_MOD) + (size_t)l * 5 * 12288;
#pragma unroll
        for (int j = 0; j < 3; ++j) { const int col = cb * 768 + j * 256 + lane * 4;
            f32x4 b = (f32x4){0.f, 0.f, 0.f, 0.f}; if (dch == 0) b = *(const f32x4*)(P.in[I_BADA] + (size_t)l * 12288 + col);
#pragma unroll
            for (int v = 0; v < 5; ++v) { const f32x4 a = acc[v][j] + b; float* mp = mod + (size_t)v * 12288 + col;
                atomicAdd(mp + 0, a[0]); atomicAdd(mp + 1, a[1]); atomicAdd(mp + 2, a[2]); atomicAdd(mp + 3, a[3]); } }
    }
    if (gw == NGW - 1) {
        float* tab = (float*)(ws + WS_TAB);
        for (int i = lane; i < 1024; i += 64) { const int pos = i >> 4, j = i & 15; const float fr = powf(10000.0f, -(float)j / 16.0f), a = (float)pos * fr; tab[TB_C64 + i] = cosf(a); tab[TB_S64 + i] = sinf(a); }
        for (int i = lane; i < 2048; i += 64) { const int pos = i >> 5, j = i & 31; const float fr = powf(10000.0f, -(float)j / 32.0f), a = (float)pos * fr; tab[TB_C128 + i] = cosf(a); tab[TB_S128 + i] = sinf(a); }
        for (int l = 0; l < 2; ++l) {
            const float d1 = wave_sum(P.in[I_LQ1][l * 64 + lane] * P.in[I_LK1][l * 64 + lane]), d2 = wave_sum(P.in[I_LQ2][l * 64 + lane] * P.in[I_LK2][l * 64 + lane]);
            const float lam_init = 0.8f - 0.6f * expf(-0.3f * (float)l);
            if (lane == 0) { tab[TB_LAM + 2 * l] = expf(d1) - expf(d2) + lam_init; tab[TB_LAM + 2 * l + 1] = lam_init; }
        }
    }
    LAS unsigned* scr = (LAS unsigned*)(lds + wave * 16384);
    constexpr int IT_IN = 64 * 205, IT_OUT = 64 * 64, IT_UQ = 12 * 24, IT_UKV = 8 * 32, IT_PAD = 192, IT_L = IT_IN + IT_OUT + IT_UQ + IT_UKV + IT_PAD;
    for (int it = gw; it < 2 * IT_L; it += NGW) {
        const int l = it / IT_L; int r = it - l * IT_L;
        if (r < IT_IN) { const int kb = r / 205, nb = r - kb * 205, nn = nb * 64; const int ns = nn < 5376 ? nn : (nn < 13056 ? nn + 64 : nn - 13056 + 5376);
            transpose_item(P.in[I_WIN] + (size_t)l * DM * INC, INC, kb * 64, ns, (bf16_t*)(ws + WS_BT1 + l * BT1_L), DM, nn, scr, lane); continue; }
        r -= IT_IN;
        if (r < IT_OUT) { const int kb = r >> 6, nb = r & 63; transpose_item(P.in[I_WOUT] + (size_t)l * DM * DM, DM, kb * 64, nb * 64, (bf16_t*)(ws + WS_BT2 + l * BT2_L), DM, nb * 64, scr, lane); continue; }
        r -= IT_OUT;
        if (r < IT_UQ) { const int kb = r / 24, nb = r - kb * 24; transpose_item(P.in[I_WUQ] + (size_t)l * 768 * 1536, 1536, kb * 64, nb * 64, (bf16_t*)(ws + WS_BUQ + l * BUQ_L), 768, nb * 64, scr, lane); continue; }
        r -= IT_UQ;
        if (r < IT_UKV) { const int kb = r >> 5, nb = r & 31; transpose_item(P.in[I_WUKV] + (size_t)l * 512 * 2048, 2048, kb * 64, nb * 64, (bf16_t*)(ws + WS_BUKV + l * BUKV_L), 512, nb * 64, scr, lane); continue; }
        r -= IT_UKV;
        { u32x4* p = (u32x4*)((bf16_t*)(ws + WS_BT1 + l * BT1_L) + (size_t)(INC + r) * DM) + lane;
#pragma unroll
          for (int j = 0; j < 8; ++j) p[64 * j] = (u32x4){0u, 0u, 0u, 0u}; }
    }
}

__device__ __forceinline__ void ph_norm(const Params& P, int l) {
    PH_IDS();
    PH_WS();
    const float* mod = (const float*)(ws + WS_CTL + CTL_MOD) + (size_t)l * 5 * 12288;
    const float* g = P.in[I_NORMG] + (size_t)l * DM;
    bf16_t* H = (bf16_t*)(ws + WS_H);
    for (int tok = gw; tok < NTOK; tok += NGW) {
        const float* xr = l == 0 ? (tok < NP ? P.in[I_XP] + (size_t)tok * DM : P.in[I_XS] + (size_t)(tok - NP) * DM) : (const float*)(ws + WS_X) + (size_t)tok * DM;
        const int v = tok < NP ? 0 : 1 + ((tok - NP) >> 11);
        const float* mv = mod + (size_t)v * 12288;
        f32x4 x[16]; float ss = 0.f;
#pragma unroll
        for (int j = 0; j < 16; ++j) { x[j] = *(const f32x4*)(xr + (j * 64 + lane) * 4); ss += (x[j][0] * x[j][0] + x[j][1] * x[j][1]) + (x[j][2] * x[j][2] + x[j][3] * x[j][3]); }
        const float rstd = 1.0f / sqrtf(wave_sum(ss) * (1.0f / DM) + EPS);
        bf16_t* hr = H + (size_t)tok * DM;
#pragma unroll
        for (int j = 0; j < 16; ++j) { const int c = (j * 64 + lane) * 4; const f32x4 gg = *(const f32x4*)(g + c), sh = *(const f32x4*)(mv + c), scl = *(const f32x4*)(mv + 4096 + c);
            const f32x4 y = (x[j] * rstd) * gg * (scl + 1.0f) + sh;
            u32x2 w; w.x = pk2(y[0], y[1]); w.y = pk2(y[2], y[3]); *(u32x2*)(hr + c) = w; }
    }
}

__device__ __forceinline__ void ld16(const bf16_t* p, float (&x)[16]) { const u32x4 a = *(const u32x4*)p, b = *(const u32x4*)(p + 8);
    x[0] = bflo(a.x); x[1] = bfhi(a.x); x[2] = bflo(a.y); x[3] = bfhi(a.y); x[4] = bflo(a.z); x[5] = bfhi(a.z); x[6] = bflo(a.w); x[7] = bfhi(a.w);
    x[8] = bflo(b.x); x[9] = bfhi(b.x); x[10] = bflo(b.y); x[11] = bfhi(b.y); x[12] = bflo(b.z); x[13] = bfhi(b.z); x[14] = bflo(b.w); x[15] = bfhi(b.w); }
__device__ __forceinline__ void st16(bf16_t* p, const float (&x)[16]) { u32x4 a, b; a.x = pk2(x[0], x[1]); a.y = pk2(x[2], x[3]); a.z = pk2(x[4], x[5]); a.w = pk2(x[6], x[7]);
    b.x = pk2(x[8], x[9]); b.y = pk2(x[10], x[11]); b.z = pk2(x[12], x[13]); b.w = pk2(x[14], x[15]); *(u32x4*)p = a; *(u32x4*)(p + 8) = b; }
__device__ __forceinline__ void st16f(float* p, const float (&x)[16]) {
#pragma unroll
    for (int j = 0; j < 4; ++j) *(f32x4*)(p + 4 * j) = (f32x4){x[4 * j], x[4 * j + 1], x[4 * j + 2], x[4 * j + 3]}; }
__device__ __forceinline__ void ld4(const bf16_t* p, float (&x)[4]) { const u32x2 a = *(const u32x2*)p; x[0] = bflo(a.x); x[1] = bfhi(a.x); x[2] = bflo(a.y); x[3] = bfhi(a.y); }
__device__ __forceinline__ void st4(bf16_t* p, const float (&x)[4]) { u32x2 a; a.x = pk2(x[0], x[1]); a.y = pk2(x[2], x[3]); *(u32x2*)p = a; }
__device__ __forceinline__ void cvt16(const float* src, bf16_t* dst) { float x[16];
#pragma unroll
    for (int j = 0; j < 4; ++j) { const f32x4 v = *(const f32x4*)(src + 4 * j); x[4 * j] = v[0]; x[4 * j + 1] = v[1]; x[4 * j + 2] = v[2]; x[4 * j + 3] = v[3]; }
    st16(dst, x); }

__device__ __forceinline__ void ph_post(const Params& P, int l) {
    PH_IDS();
    PH_WS();
    bf16_t* Z = (bf16_t*)(ws + WS_Z);
    const float* tab = (const float*)(ws + WS_TAB);
    float* out = P.out;
    for (int r = gw; r < NKV; r += NGW) {
        bf16_t* zr = Z + (size_t)r * LDZ;
        bool lat = false; int t = 0, pb = 0, lb = 0, cp = -1;
        if (r < NP) { pb = r >> 8; t = r & 255; }
        else { const int rr = r - NP; lb = rr / LKV; const int s = rr - lb * LKV; if (s < LSEQ) { lat = true; t = s; } else cp = s - LSEQ; }
        if (cp >= 0) {
            const size_t ci = (size_t)(lb * 2 + l) * PAST + cp;
            cvt16(P.in[I_CAK] + ci * 1024 + lane * 16, zr + ZC_AK + lane * 16);
            cvt16(P.in[I_CAV] + ci * 1024 + lane * 16, zr + ZC_AV + lane * 16);
            cvt16(P.in[I_CDK] + ci * 1024 + lane * 16, zr + ZC_DK + lane * 16);
            cvt16(P.in[I_CDV] + ci * 1024 + lane * 16, zr + ZC_DV + lane * 16);
            { const f32x4 a = *(const f32x4*)(P.in[I_CCK] + ci * 256 + lane * 4); float x[4] = {a[0], a[1], a[2], a[3]}; st4(zr + ZC_CK + lane * 4, x); }
            { const f32x4 a = *(const f32x4*)(P.in[I_CCV] + ci * 256 + lane * 4); float x[4] = {a[0], a[1], a[2], a[3]}; st4(zr + ZC_CV + lane * 4, x); }
            { const f32x4 a = *(const f32x4*)(P.in[I_CBCKV] + ci * 512 + lane * 8), b = *(const f32x4*)(P.in[I_CBCKV] + ci * 512 + lane * 8 + 4);
              u32x4 w; w.x = pk2(a[0], a[1]); w.y = pk2(a[2], a[3]); w.z = pk2(b[0], b[1]); w.w = pk2(b[2], b[3]); *(u32x4*)(zr + ZC_BCKV + lane * 8) = w; }
            zr[ZC_BKPE + lane] = (bf16_t)f2bf(P.in[I_CBKPE][ci * 64 + lane]);
            continue;
        }
        const size_t po = (size_t)(pb * 2 + l) * PSEQ + t;
        const int prow = t >> 6, pcol = t & 63;
        { float x[3][4]; float ss = 0.f;
#pragma unroll
          for (int j = 0; j < 3; ++j) { ld4(zr + ZC_BCQ + (lane + 64 * j) * 4, x[j]); ss += (x[j][0] * x[j][0] + x[j][1] * x[j][1]) + (x[j][2] * x[j][2] + x[j][3] * x[j][3]); }
          const float rstd = 1.0f / sqrtf(wave_sum(ss) * (1.0f / 768.0f) + EPS);
#pragma unroll
          for (int j = 0; j < 3; ++j) { const f32x4 g = *(const f32x4*)(P.in[I_BQN] + (size_t)l * 768 + (lane + 64 * j) * 4);
              float y[4] = {x[j][0] * rstd * g[0], x[j][1] * rstd * g[1], x[j][2] * rstd * g[2], x[j][3] * rstd * g[3]}; st4(zr + ZC_BCQ + (lane + 64 * j) * 4, y); } }
        { const u32x4 w = *(const u32x4*)(zr + ZC_BCKV + lane * 8);
          float x[8] = {bflo(w.x), bfhi(w.x), bflo(w.y), bfhi(w.y), bflo(w.z), bfhi(w.z), bflo(w.w), bfhi(w.w)}; float ss = 0.f;
#pragma unroll
          for (int e = 0; e < 8; ++e) ss += x[e] * x[e];
          const float rstd = 1.0f / sqrtf(wave_sum(ss) * (1.0f / 512.0f) + EPS);
          const f32x4 g0 = *(const f32x4*)(P.in[I_BKVN] + (size_t)l * 512 + lane * 8), g1 = *(const f32x4*)(P.in[I_BKVN] + (size_t)l * 512 + lane * 8 + 4);
          float y[8] = {x[0] * rstd * g0[0], x[1] * rstd * g0[1], x[2] * rstd * g0[2], x[3] * rstd * g0[3], x[4] * rstd * g1[0], x[5] * rstd * g1[1], x[6] * rstd * g1[2], x[7] * rstd * g1[3]};
          u32x4 o; o.x = pk2(y[0], y[1]); o.y = pk2(y[2], y[3]); o.z = pk2(y[4], y[5]); o.w = pk2(y[6], y[7]); *(u32x4*)(zr + ZC_BCKV + lane * 8) = o;
          if (!lat) { float* op = out + O_BCKV + po * 512 + lane * 8; *(f32x4*)op = (f32x4){y[0], y[1], y[2], y[3]}; *(f32x4*)(op + 4) = (f32x4){y[4], y[5], y[6], y[7]}; } }
        { const float x = bf2f(zr[ZC_BKPE + lane]);
          if (!lat) out[O_BKPE + po * 64 + lane] = x;
          else { const float xp = shx<16>(x); const int pos = lane < 32 ? prow : pcol, j = lane & 15; const float cs = tab[TB_C64 + pos * 16 + j], sn = tab[TB_S64 + pos * 16 + j];
              const float y = (lane & 16) ? x * cs + xp * sn : x * cs - xp * sn; zr[ZC_BKPE + lane] = (bf16_t)f2bf(y); } }
        { float x[16]; ld16(zr + ZC_CQ + lane * 16, x); float ss = 0.f;
#pragma unroll
          for (int e = 0; e < 16; ++e) ss += x[e] * x[e];
          ss += shx<1>(ss); ss += shx<2>(ss); ss += shx<4>(ss);
          const float rstd = 1.0f / sqrtf(ss * (1.0f / 128.0f) + EPS); const int lh = lane & 7;
#pragma unroll
          for (int e = 0; e < 16; ++e) x[e] = x[e] * rstd * P.in[I_CQN][l * 128 + lh * 16 + e];
          if (lat) { const int q = lh >> 1, pos = q < 2 ? prow : pcol, fb = (lh & 1) * 16; const bool second = q & 1;
#pragma unroll
              for (int e = 0; e < 16; ++e) { const float xp = shx<2>(x[e]); const float cs = tab[TB_C128 + pos * 32 + fb + e], sn = tab[TB_S128 + pos * 32 + fb + e];
                  x[e] = second ? x[e] * cs + xp * sn : x[e] * cs - xp * sn; } }
          st16(zr + ZC_CQ + lane * 16, x); }
        { float x[4]; ld4(zr + ZC_CK + lane * 4, x); float ss = (x[0] * x[0] + x[1] * x[1]) + (x[2] * x[2] + x[3] * x[3]);
          ss += shx<1>(ss); ss += shx<2>(ss); ss += shx<4>(ss); ss += shx<8>(ss); ss += shx<16>(ss);
          const float rstd = 1.0f / sqrtf(ss * (1.0f / 128.0f) + EPS); const int lh = lane & 31;
#pragma unroll
          for (int e = 0; e < 4; ++e) x[e] = x[e] * rstd * P.in[I_CKN][l * 128 + lh * 4 + e];
          if (!lat) *(f32x4*)(out + O_CK + po * 256 + lane * 4) = (f32x4){x[0], x[1], x[2], x[3]};
          else { const int q = lh >> 3, pos = q < 2 ? prow : pcol, fb = (lh & 7) * 4; const bool second = q & 1;
#pragma unroll
              for (int e = 0; e < 4; ++e) { const float xp = shx<8>(x[e]); const float cs = tab[TB_C128 + pos * 32 + fb + e], sn = tab[TB_S128 + pos * 32 + fb + e];
                  x[e] = second ? x[e] * cs + xp * sn : x[e] * cs - xp * sn; } }
          st4(zr + ZC_CK + lane * 4, x); }
        if (!lat) { float x[4]; ld4(zr + ZC_CV + lane * 4, x); *(f32x4*)(out + O_CV + po * 256 + lane * 4) = (f32x4){x[0], x[1], x[2], x[3]}; }
        {   const int lv = lane & 3, pos = lv < 2 ? prow : pcol; const bool second = lv & 1;
            if (lat) {
#pragma unroll
                for (int w = 0; w < 2; ++w) { bf16_t* p = zr + (w == 0 ? ZC_DQ : ZC_DK) + lane * 16; float x[16]; ld16(p, x);
#pragma unroll
                    for (int e = 0; e < 16; ++e) { const float xp = shx<1>(x[e]); const float cs = tab[TB_C64 + pos * 16 + e], sn = tab[TB_S64 + pos * 16 + e];
                        x[e] = second ? x[e] * cs + xp * sn : x[e] * cs - xp * sn; }
                    st16(p, x); }
            } else { float x[16]; ld16(zr + ZC_DK + lane * 16, x); st16f(out + O_DK + po * 1024 + lane * 16, x); } }
        if (!lat) { float x[16]; ld16(zr + ZC_DV + lane * 16, x); st16f(out + O_DV + po * 1024 + lane * 16, x);
            ld16(zr + ZC_AK + lane * 16, x); st16f(out + O_AK + po * 1024 + lane * 16, x);
            ld16(zr + ZC_AV + lane * 16, x); st16f(out + O_AV + po * 1024 + lane * 16, x); }
    }
}

__device__ __forceinline__ void ph_final(const Params& P) {
    PH_IDS();
    PH_WS();
    const float* X = (const float*)(ws + WS_X); const float* g = P.in[I_FNG];
    for (int tok = gw; tok < NTOK; tok += NGW) {
        const float* xr = X + (size_t)tok * DM; f32x4 x[16]; float ss = 0.f;
#pragma unroll
        for (int j = 0; j < 16; ++j) { x[j] = *(const f32x4*)(xr + (j * 64 + lane) * 4); ss += (x[j][0] * x[j][0] + x[j][1] * x[j][1]) + (x[j][2] * x[j][2] + x[j][3] * x[j][3]); }
        const float rstd = 1.0f / sqrtf(wave_sum(ss) * (1.0f / DM) + EPS);
        float* orow = P.out + (size_t)tok * DM;
#pragma unroll
        for (int j = 0; j < 16; ++j) { const int c = (j * 64 + lane) * 4; *(f32x4*)(orow + c) = (x[j] * rstd) * *(const f32x4*)(g + c); }
    }
}

constexpr int N_PHASES = 14;
__global__ void __launch_bounds__(NTHR, 2) fwd_kernel(Params P) {
    extern __shared__ __attribute__((aligned(16))) unsigned char lds_raw[];
    LAS unsigned char* lds = (LAS unsigned char*)lds_raw;
    volatile LAS unsigned* MISC = (volatile LAS unsigned*)(lds + MISC_OFF);
    const int tid = threadIdx.x;
    const int G = gridDim.x;
    unsigned* ctl = (unsigned*)(P.ws + WS_CTL);
    if (tid < 32) MISC[tid] = 0u;
    __syncthreads();
    XcdBarrier bar; bar.bar = ctl + CW_BAR; bar.x = 0; bar.st = nullptr;
    if (MK_MODE == 0) bar = xcd_barrier_post(ctl + CW_BAR, MISC + 8);
    const int lo = P.ph_lo, hi = P.ph_hi;
#ifndef PH_MASK
#define PH_MASK 0x3fffu
#endif
#define IN(k) (((PH_MASK >> (k)) & 1u) && lo <= (k) && (k) < hi)
#define SEAM(k) do { if (IN(k) && IN((k) + 1)) xcd_barrier(bar); } while (0)
    if (IN(0)) { ph_prologue(P, lds, true); if (PROBE_DUP & 256) ph_prologue(P, lds, false); }
    SEAM(0);
    for (int l = 0; l < DEPTH; ++l) {
        const int pb = 1 + 6 * l;
        if (IN(pb + 0)) { ph_norm(P, l); if (PROBE_DUP & 512) ph_norm(P, l); }
        SEAM(pb + 0);
        for (int rep_ = 0; rep_ < ((PROBE_DUP & 2) ? 2 : 1); ++rep_)
        if (IN(pb + 1)) { PH_WS();
            pg8::Gemm g{(const bf16_t*)(ws + WS_H), (const bf16_t*)(ws + WS_BT1 + l * BT1_L), NTOK, LDZ, DM, DM, DM}; pg8::StaticOrder S; S.init(NTOK, LDZ, G, (int)blockIdx.x);
            pg8::EpiBf16 E{(bf16_t*)(ws + WS_Z), LDZ, 1};
            pg8::gemm_phase<pg8::EpiBf16, pg8::StaticOrder>(lds, g, S, E);
        }
        SEAM(pb + 1);
        if (IN(pb + 2)) ph_post(P, l);
        SEAM(pb + 2);
        for (int rep_ = 0; rep_ < ((PROBE_DUP & 8) ? 2 : 1); ++rep_)
        if (IN(pb + 3)) { PH_WS();
            { pg8::Gemm g{(const bf16_t*)(ws + WS_Z) + ZC_BCQ, (const bf16_t*)(ws + WS_BUQ + l * BUQ_L), NKV, 1536, 768, LDZ, 768}; pg8::StaticOrder S; S.init(NKV, 1536, G, (int)blockIdx.x);
              pg8::EpiBf16 E{(bf16_t*)(ws + WS_QB), LDQB, 0};
              pg8::gemm_phase<pg8::EpiBf16, pg8::StaticOrder>(lds, g, S, E); }
            { pg8::Gemm g{(const bf16_t*)(ws + WS_Z) + ZC_BCKV, (const bf16_t*)(ws + WS_BUKV + l * BUKV_L), NKV, 2048, 512, LDZ, 512}; pg8::StaticOrder S; S.init(NKV, 2048, G, G - 1 - (int)blockIdx.x);
              pg8::EpiBf16 E{(bf16_t*)(ws + WS_KVB), LDKVB, 0};
              pg8::gemm_phase<pg8::EpiBf16, pg8::StaticOrder>(lds, g, S, E); }
        }
        SEAM(pb + 3);
        if (IN(pb + 4)) { PH_WS();
            for (int rnd = 0; rnd < ((PROBE_DUP & 32) ? 4 : 2); ++rnd) {
#define ATT_SECT(sect, DQV, KWV, MSK, DPR) do { const int nu_ = attn_nunits(sect, rnd & 1); unsigned* qc_ = ctl + CW_Q + 64 * ((l * 4 + rnd) * 4 + sect); \
                for (;;) { if (tid == 0) MISC[16] = atomicAdd(qc_, 1u); __syncthreads(); const int idx_ = (int)MISC[16]; __syncthreads(); if (idx_ >= nu_) break; \
                    const AttnUnit U = make_unit(sect, rnd & 1, idx_, l, (bf16_t*)(ws + WS_Z), (bf16_t*)(ws + WS_QB), (bf16_t*)(ws + WS_KVB), (bf16_t*)(ws + WS_Y), P.in[I_RPB], (const float*)(ws + WS_TAB), P.in[I_SUBLN]); \
                    att::attn_body<DQV, KWV, MSK, DPR>(U, (char*)lds_raw); } } while (0)
#ifndef SECT_MASK
#define SECT_MASK 15
#endif
                if (SECT_MASK & 1) ATT_SECT(0, 192, 192, false, false);
                if (SECT_MASK & 2) ATT_SECT(1, 128, 128, false, false);
                if (SECT_MASK & 4) ATT_SECT(2, 64, 128, false, true);
                if ((SECT_MASK & 8) && (rnd & 1) == 0) ATT_SECT(3, 128, 128, true, false);
#undef ATT_SECT
            }
        }
        SEAM(pb + 4);
        for (int rep_ = 0; rep_ < (((PROBE_DUP & 64) && l == 0) ? 3 : 1); ++rep_)
        if (IN(pb + 5)) { PH_WS();
            pg8::Gemm g{(const bf16_t*)(ws + WS_Y), (const bf16_t*)(ws + WS_BT2 + l * BT2_L), NTOK, DM, DM, DM, DM}; pg8::StaticOrder S; S.init(NTOK, DM, G, (int)blockIdx.x);
            const float* xp = l == 0 ? P.in[I_XP] : (const float*)(ws + WS_X); const float* xl = l == 0 ? P.in[I_XS] : (const float*)(ws + WS_X) + (size_t)NP * DM;
            pg8::EpiRes E{xp, xl, (float*)(ws + WS_X), (const float*)(ws + WS_CTL + CTL_MOD) + (size_t)l * 5 * 12288 + 8192};
            pg8::gemm_phase<pg8::EpiRes, pg8::StaticOrder>(lds, g, S, E);
        }
        SEAM(pb + 5);
    }
    if (IN(13)) { ph_final(P); if (PROBE_DUP & 2048) ph_final(P); }
#undef IN
#undef SEAM
}

extern "C" void kernel_launch(void* const* d_in, const int* in_sizes, int n_in, void* d_out, int out_size, void* d_ws, size_t ws_size, hipStream_t stream) {
    static int grid = 0;
    if (grid == 0) {
        if (n_in != 30 || (size_t)out_size != O_END || ws_size < WS_END) { fprintf(stderr, "kernel_launch: shape mismatch: n_in %d out %d ws %zu (need %zu)\n", n_in, out_size, ws_size, (size_t)WS_END); grid = -1; return; }
        int dev = 0, cus = 0, per_cu = 0;
        if (hipGetDevice(&dev) != hipSuccess || hipDeviceGetAttribute(&cus, hipDeviceAttributeMultiprocessorCount, dev) != hipSuccess) { fprintf(stderr, "kernel_launch: device query failed\n"); grid = -1; return; }
        if (hipFuncSetAttribute((const void*)fwd_kernel, hipFuncAttributeMaxDynamicSharedMemorySize, LDS_BYTES) != hipSuccess) { fprintf(stderr, "kernel_launch: hipFuncSetAttribute failed\n"); grid = -1; return; }
        if (hipOccupancyMaxActiveBlocksPerMultiprocessor(&per_cu, (const void*)fwd_kernel, NTHR, LDS_BYTES) != hipSuccess || per_cu < 1)
            fprintf(stderr, "kernel_launch: note: occupancy query reports %d workgroups per CU\n", per_cu);
        (void)hipGetLastError();
        grid = cus;
    }
    if (grid < 0) return;
    if (hipMemsetAsync((char*)d_ws + WS_CTL, 0, CTL_BYTES, stream) != hipSuccess) { fprintf(stderr, "kernel_launch: memset failed\n"); return; }
    Params p{};
    for (int i = 0; i < 30; ++i) p.in[i] = (const float*)d_in[i];
    p.out = (float*)d_out; p.ws = (unsigned char*)d_ws;
#if MK_MODE == 0
    p.ph_lo = 0; p.ph_hi = N_PHASES;
    hipLaunchKernelGGL(fwd_kernel, dim3(grid), dim3(NTHR), LDS_BYTES, stream, p);
#else
    for (int ph = 0; ph < N_PHASES; ++ph) {
        p.ph_lo = ph; p.ph_hi = ph + 1;
        hipLaunchKernelGGL(fwd_kernel, dim3(grid), dim3(NTHR), LDS_BYTES, stream, p);
    }
#endif
    const hipError_t le = hipPeekAtLastError();
    if (le != hipSuccess) fprintf(stderr, "kernel_launch: launch failed: %s\n", hipGetErrorName(le));
}
```

```cpp
#include <hip/hip_runtime.h>
#include <cstdio>
#include <cstdint>

#ifndef MK_MODE
#define MK_MODE 0
#endif
#ifndef PROBE_DUP
#define PROBE_DUP 0
#endif
#ifndef PROBE_T
#define PROBE_T 0
#endif
#ifndef PROBE_T2
#define PROBE_T2 0
#endif
#ifndef PROBE_TC
#define PROBE_TC 0
#endif
#ifndef PROBE_MUL
#define PROBE_MUL 1
#endif
#ifndef PROBE_SLEEP
#define PROBE_SLEEP 0
#endif
#ifndef PROBE_CLK_L
#define PROBE_CLK_L 0
#endif
#ifndef PROBE_CLK
#define PROBE_CLK 0
#endif

#define LAS __attribute__((address_space(3)))
#define GLOBAL_PTR(T, p) ((T*)(__attribute__((address_space(1))) T*)(unsigned long long)(p))
typedef unsigned short bf16_t;
typedef short bf16x8 __attribute__((ext_vector_type(8)));
typedef short s16x4 __attribute__((ext_vector_type(4)));
typedef float f32x4 __attribute__((ext_vector_type(4)));
typedef float f32x2 __attribute__((ext_vector_type(2)));
typedef float f32x16 __attribute__((ext_vector_type(16)));
typedef unsigned u32x4 __attribute__((ext_vector_type(4)));
typedef unsigned u32x2 __attribute__((ext_vector_type(2)));

constexpr int DM = 4096, NPB = 16, PSEQ = 256, NLB = 4, LSEQ = 2048, PAST = 256, DEPTH = 2;
constexpr int NP = NPB * PSEQ, NL = NLB * LSEQ, NTOK = NP + NL;
constexpr int LKV = LSEQ + PAST, NKV = NP + NLB * LKV;
constexpr int INC = 13120, LDZ = 13312;
constexpr float EPS = 1e-6f;
constexpr int ZC_AQ = 0, ZC_AK = 1024, ZC_AV = 2048, ZC_AZ = 3072, ZC_BCQ = 4096, ZC_BCKV = 4864, ZC_BZ = 5376, ZC_CQ = 6400, ZC_CK = 7424, ZC_CV = 7680,
              ZC_CZ = 7936, ZC_DQ = 8960, ZC_DK = 9984, ZC_DV = 11008, ZC_DZ = 12032, ZC_BKPE = 13056;
constexpr int LDQB = 1536, LDKVB = 2048, LDO = 5120;
constexpr size_t O_YP = 0, O_YS = 16777216, O_AK = 50331648, O_AV = 58720256, O_BCKV = 67108864, O_BKPE = 71303168, O_CK = 71827456, O_CV = 73924608,
                 O_DK = 76021760, O_DV = 84410368, O_END = 92798976;
constexpr size_t MiB = 1u << 20;
constexpr size_t WS_CTL = 0, CTL_BYTES = 1 * MiB;
constexpr int CW_BAR = 4096;
constexpr int CW_Q = 8192;
constexpr size_t CTL_RSS = 600064;
constexpr size_t CTL_MOD = 65536;
constexpr size_t WS_TAB = 1 * MiB;
constexpr size_t WS_BT1 = 2 * MiB, BT1_L = (size_t)LDZ * DM * 2;
constexpr size_t WS_BT2 = WS_BT1 + 2 * BT1_L, BT2_L = (size_t)DM * DM * 2;
constexpr size_t WS_BUQ = WS_BT2 + 2 * BT2_L, BUQ_L = (size_t)1536 * 768 * 2;
constexpr size_t WS_BUKV = WS_BUQ + 2 * BUQ_L, BUKV_L = (size_t)2048 * 512 * 2;
constexpr size_t WS_H = WS_BUKV + 2 * BUKV_L;
constexpr size_t WS_Z = WS_H + (size_t)NTOK * DM * 2;
constexpr size_t WS_QB = WS_Z + (size_t)NKV * LDZ * 2;
constexpr size_t WS_KVB = WS_QB + (size_t)NKV * LDQB * 2;
constexpr size_t WS_OB = WS_KVB + (size_t)NKV * LDKVB * 2;
constexpr size_t WS_Y = WS_OB + (size_t)NTOK * LDO * 2;
constexpr size_t WS_X = WS_Y + (size_t)NTOK * DM * 2;
constexpr size_t WS_END = WS_X + (size_t)NTOK * DM * 4;
static_assert(WS_BT1 % 256 == 0 && WS_BT2 % 256 == 0 && WS_BUQ % 256 == 0 && WS_BUKV % 256 == 0 && WS_H % 256 == 0 && WS_Z % 256 == 0 && WS_QB % 256 == 0 && WS_KVB % 256 == 0 &&
              WS_OB % 256 == 0 && WS_Y % 256 == 0 && WS_X % 256 == 0, "ws alignment");
constexpr int TB_C64 = 0, TB_S64 = 1024, TB_C128 = 2048, TB_S128 = 4096, TB_LAM = 6144;
constexpr int RING_BYTES = 131072, ATT_WSF_OFF = 131072, ATT_RPB_OFF = 133120, MISC_OFF = 143360, LDS_BYTES = 147456;
constexpr int NWAVES = 8, NTHR = 512;

#define LDS_WAIT() asm volatile("s_waitcnt lgkmcnt(0)" ::: "memory")
#define VM_WAIT() asm volatile("s_waitcnt vmcnt(0)" ::: "memory")
__device__ __forceinline__ unsigned f2bf(float f) { unsigned u = __builtin_bit_cast(unsigned, f); return (u + 0x7fffu + ((u >> 16) & 1u)) >> 16; }
__device__ __forceinline__ unsigned pk2(float lo, float hi) { return f2bf(lo) | (f2bf(hi) << 16); }
__device__ __forceinline__ float bf2f(unsigned short b) { return __builtin_bit_cast(float, ((unsigned)b) << 16); }
__device__ __forceinline__ float bflo(unsigned w) { return __builtin_bit_cast(float, w << 16); }
__device__ __forceinline__ float bfhi(unsigned w) { return __builtin_bit_cast(float, w & 0xffff0000u); }
__device__ __forceinline__ unsigned cvt_pk_bf16(float lo, float hi) { unsigned r; asm volatile("v_cvt_pk_bf16_f32 %0, %1, %2" : "=v"(r) : "v"(lo), "v"(hi)); return r; }
template <int M> __device__ __forceinline__ float shx(float x) {
    if constexpr (M < 32) return __builtin_bit_cast(float, __builtin_amdgcn_ds_swizzle(__builtin_bit_cast(int, x), (M << 10) | 0x1f));
    else { auto rr = __builtin_amdgcn_permlane32_swap(__builtin_bit_cast(unsigned, x), __builtin_bit_cast(unsigned, x), false, false);
           return __builtin_bit_cast(float, (unsigned)rr[0]) == x ? __builtin_bit_cast(float, (unsigned)rr[1]) : __builtin_bit_cast(float, (unsigned)rr[0]); }
}
__device__ __forceinline__ float wave_sum(float v) {
    v += shx<1>(v); v += shx<2>(v); v += shx<4>(v); v += shx<8>(v); v += shx<16>(v);
    auto rr = __builtin_amdgcn_permlane32_swap(__builtin_bit_cast(unsigned, v), __builtin_bit_cast(unsigned, v), false, false);
    return __builtin_bit_cast(float, (unsigned)rr[0]) + __builtin_bit_cast(float, (unsigned)rr[1]);
}
__device__ __forceinline__ float wave_max(float v) {
    v = fmaxf(v, shx<1>(v)); v = fmaxf(v, shx<2>(v)); v = fmaxf(v, shx<4>(v)); v = fmaxf(v, shx<8>(v)); v = fmaxf(v, shx<16>(v));
    auto rr = __builtin_amdgcn_permlane32_swap(__builtin_bit_cast(unsigned, v), __builtin_bit_cast(unsigned, v), false, false);
    return fmaxf(__builtin_bit_cast(float, (unsigned)rr[0]), __builtin_bit_cast(float, (unsigned)rr[1]));
}
__device__ __forceinline__ int lane_id() { int l; asm volatile("v_mbcnt_lo_u32_b32 %0, -1, 0\n\tv_mbcnt_hi_u32_b32 %0, -1, %0" : "=v"(l)); return l; }
__device__ __forceinline__ float silu_f(float x) { return x / (1.0f + __expf(-x)); }
__device__ __forceinline__ int kvrow_of_tok(int tok) { if (tok < NP) return tok; const int r = tok - NP; return NP + (r >> 11) * LKV + (r & 2047); }

namespace pg8 {
constexpr int BM = 256, BK = 64, HALF = 128, HTB = HALF * BK * 2, STAGE_BYTES = 8 * HTB, NXCD = 8, WGM = 8;
__host__ __device__ __forceinline__ int lds_byte(int r, int c) { const int st = (r >> 4) * 2 + (c >> 5), rr = r & 15, cc = c & 31, ob = rr * 64 + cc * 2; return st * 1024 + (ob ^ (((ob >> 9) & 1) << 5)); }
__host__ __device__ __forceinline__ void stage_rc(int b, int& R, int& C) { const int st = b / 1024, sb = b % 1024, swz = sb ^ (((sb >> 9) & 1) << 5); R = (st >> 1) * 16 + swz / 64; C = (st & 1) * 32 + (swz % 64) / 2; }
__host__ __device__ __forceinline__ int perm32(int rho) { const int n = rho >> 4, i = rho & 15; return 8 * (i >> 2) + 4 * n + (i & 3); }

struct Unit { int pm, pn; };
struct Gemm { const bf16_t* A; const bf16_t* Bt; int M, N, K, lda, ldb; };

struct StaticOrder {
    int nM, nN, nwg, G, c;
    __host__ __device__ void init(int M, int N, int G_, int c_) { nM = M / BM; nN = N / BM; nwg = nM * nN; G = G_; c = c_; }
    __host__ __device__ bool next(int i, Unit& u) const {
        const long L = (long)i * G + c; if (L >= nwg) return false;
        int wgid = (int)L; { const int q = nwg / NXCD, r = nwg % NXCD, xcd = wgid % NXCD, off = wgid / NXCD; wgid = (xcd < r ? xcd * (q + 1) : r * (q + 1) + (xcd - r) * q) + off; }
        const int nig = WGM * nN, gid = wgid / nig, fm = gid * WGM, gsz = (nM - fm) < WGM ? (nM - fm) : WGM;
        u.pm = fm + ((wgid % nig) % gsz); u.pn = (wgid % nig) / gsz; return true;
    }
    __device__ __forceinline__ void a_ready(const Unit&) const {}
    __device__ __forceinline__ void done(const Unit&) const {}
};

struct EpiBf16 {
    static constexpr bool PERM = true;
    bf16_t* O; int ldc; int remap;
    __device__ __forceinline__ void operator()(const f32x4 (&acc)[2][2][4][2], const Unit& u, int wr, int wc, int fr, int fq) const {
        int pmo = u.pm; if (remap && pmo >= 16) { const int j = pmo - 16; pmo = 16 + (j >> 3) * 9 + (j & 7); }
        const int row0 = pmo * BM + wr * 64 + fr, col0 = u.pn * BM + wc * 32 + 8 * fq;
#pragma unroll
        for (int ai = 0; ai < 2; ++ai)
#pragma unroll
            for (int m = 0; m < 4; ++m) { bf16_t* rowp = O + (size_t)(row0 + ai * HALF + m * 16) * ldc + col0;
#pragma unroll
                for (int bj = 0; bj < 2; ++bj) { const f32x4 v0 = acc[ai][bj][m][0], v1 = acc[ai][bj][m][1];
                    u32x4 w; w.x = cvt_pk_bf16(v0[0], v0[1]); w.y = cvt_pk_bf16(v0[2], v0[3]); w.z = cvt_pk_bf16(v1[0], v1[1]); w.w = cvt_pk_bf16(v1[2], v1[3]);
                    if (remap) __builtin_nontemporal_store(w, (u32x4*)(rowp + bj * HALF)); else *(u32x4*)(rowp + bj * HALF) = w; } }
    }
};
struct EpiZ {
    static constexpr bool PERM = true;
    bf16_t* O; float* out; int l; float* rss;
    __device__ __forceinline__ void operator()(const f32x4 (&acc)[2][2][4][2], const Unit& u, int wr, int wc, int fr, int fq) const {
        int pmo = u.pm; if (pmo >= 16) { const int j = pmo - 16; pmo = 16 + (j >> 3) * 9 + (j & 7); }
        const int row0 = pmo * BM + wr * 64 + fr, col0 = u.pn * BM + wc * 32 + 8 * fq;
        if (u.pn >= 16 && u.pn < 21) { float* rp = rss + (u.pn < 19 ? 0 : NKV) + row0;
#pragma unroll
            for (int ai = 0; ai < 2; ++ai)
#pragma unroll
                for (int m = 0; m < 4; ++m) { float q = 0.f;
#pragma unroll
                    for (int bj = 0; bj < 2; ++bj)
#pragma unroll
                        for (int n = 0; n < 2; ++n) { const f32x4 x = acc[ai][bj][m][n]; q += (x[0] * x[0] + x[1] * x[1]) + (x[2] * x[2] + x[3] * x[3]); }
                    q += shx<16>(q); { auto rr = __builtin_amdgcn_permlane32_swap(__float_as_uint(q), __float_as_uint(q), false, false); q = __uint_as_float(rr[0]) + __uint_as_float(rr[1]); }
                    if (fq == 0) atomicAdd(rp + ai * HALF + m * 16, q); } }
#pragma unroll
        for (int ai = 0; ai < 2; ++ai)
#pragma unroll
            for (int m = 0; m < 4; ++m) { bf16_t* rowp = O + (size_t)(row0 + ai * HALF + m * 16) * LDZ + col0;
#pragma unroll
                for (int bj = 0; bj < 2; ++bj) { const f32x4 v0 = acc[ai][bj][m][0], v1 = acc[ai][bj][m][1];
                    u32x4 w; w.x = cvt_pk_bf16(v0[0], v0[1]); w.y = cvt_pk_bf16(v0[2], v0[3]); w.z = cvt_pk_bf16(v1[0], v1[1]); w.w = cvt_pk_bf16(v1[2], v1[3]);
                    __builtin_nontemporal_store(w, (u32x4*)(rowp + bj * HALF)); } }
        if (u.pm < 16) {
            const int pn = u.pn; size_t obase; int W, cb;
            if (pn >= 4 && pn < 8) { obase = O_AK; W = 1024; cb = (pn - 4) * 256; }
            else if (pn >= 8 && pn < 12) { obase = O_AV; W = 1024; cb = (pn - 8) * 256; }
            else if (pn == 30) { obase = O_CV; W = 256; cb = 0; }
            else if (pn >= 39 && pn < 43) { obase = O_DK; W = 1024; cb = (pn - 39) * 256; }
            else if (pn >= 43 && pn < 47) { obase = O_DV; W = 1024; cb = (pn - 43) * 256; }
            else return;
            float* ob = out + obase + ((size_t)(u.pm * 2 + l) * PSEQ + wr * 64 + fr) * W + cb + wc * 32 + 8 * fq;
#pragma unroll
            for (int ai = 0; ai < 2; ++ai)
#pragma unroll
                for (int m = 0; m < 4; ++m) { float* rp = ob + (size_t)(ai * HALF + m * 16) * W;
#pragma unroll
                    for (int bj = 0; bj < 2; ++bj) { __builtin_nontemporal_store(acc[ai][bj][m][0], (f32x4*)(rp + bj * HALF)); __builtin_nontemporal_store(acc[ai][bj][m][1], (f32x4*)(rp + bj * HALF + 4)); } }
        }
    }
};
struct EpiScale {
    static constexpr bool PERM = true;
    bf16_t* O; int ldc; const float* rss; float invK; int cache1;
    __device__ __forceinline__ void operator()(const f32x4 (&acc)[2][2][4][2], const Unit& u, int wr, int wc, int fr, int fq) const {
        const int row0 = u.pm * BM + wr * 64 + fr, col0 = u.pn * BM + wc * 32 + 8 * fq;
        const bool ct = cache1 && u.pm >= 16 && ((u.pm - 16) % 9 == 8);
#pragma unroll
        for (int ai = 0; ai < 2; ++ai)
#pragma unroll
            for (int m = 0; m < 4; ++m) { const int r = row0 + ai * HALF + m * 16; const float rs = ct ? 1.0f : 1.0f / sqrtf(rss[r] * invK + EPS);
                bf16_t* rowp = O + (size_t)r * ldc + col0;
#pragma unroll
                for (int bj = 0; bj < 2; ++bj) { const f32x4 v0 = acc[ai][bj][m][0] * rs, v1 = acc[ai][bj][m][1] * rs;
                    u32x4 w; w.x = cvt_pk_bf16(v0[0], v0[1]); w.y = cvt_pk_bf16(v0[2], v0[3]); w.z = cvt_pk_bf16(v1[0], v1[1]); w.w = cvt_pk_bf16(v1[2], v1[3]);
                    *(u32x4*)(rowp + bj * HALF) = w; } }
    }
};
struct EpiDelta {
    static constexpr bool PERM = true;
    bf16_t* D; const float* gate;
    __device__ __forceinline__ void operator()(const f32x4 (&acc)[2][2][4][2], const Unit& u, int wr, int wc, int fr, int fq) const {
        const int row0 = u.pm * BM + wr * 64 + fr, col0 = u.pn * BM + wc * 32 + 8 * fq;
        const int v = u.pm < 16 ? 0 : 1 + ((u.pm - 16) >> 3);
        const float* gv = gate + (size_t)v * 12288 + col0;
        f32x4 g4[2][2];
#pragma unroll
        for (int bj = 0; bj < 2; ++bj)
#pragma unroll
            for (int n = 0; n < 2; ++n) g4[bj][n] = *(const f32x4*)(gv + bj * HALF + 4 * n);
#pragma unroll
        for (int ai = 0; ai < 2; ++ai)
#pragma unroll
            for (int m = 0; m < 4; ++m) { bf16_t* rowp = D + (size_t)(row0 + ai * HALF + m * 16) * DM + col0;
#pragma unroll
                for (int bj = 0; bj < 2; ++bj) { const f32x4 v0 = acc[ai][bj][m][0] * g4[bj][0], v1 = acc[ai][bj][m][1] * g4[bj][1];
                    u32x4 w; w.x = cvt_pk_bf16(v0[0], v0[1]); w.y = cvt_pk_bf16(v0[2], v0[3]); w.z = cvt_pk_bf16(v1[0], v1[1]); w.w = cvt_pk_bf16(v1[2], v1[3]);
                    *(u32x4*)(rowp + bj * HALF) = w; } }
    }
};

#ifndef PG8_SP2
#define PG8_SP2 true
#endif
#ifndef PG8_ALIGN
#define PG8_ALIGN true
#endif
template <class Epi, class Sched, bool ALIGN_EPI = PG8_ALIGN, bool SP2 = PG8_SP2>
__device__ __forceinline__ void gemm_phase(LAS unsigned char* lds, const Gemm g, const Sched& S, const Epi& E, int wv) {
    int lane_ = lane_id(); asm volatile("" : "+v"(lane_));
    const int wid = wv, lane = lane_, tid = wid * 64 + lane, wr = wid >> 2, wc = wid & 3, fr = lane & 15, fq = lane >> 4;
    const int K = g.K, nt = K / BK;
    unsigned voffA[2], voffB[2];
#pragma unroll
    for (int i = 0; i < 2; ++i) { int R, C; stage_rc(tid * 16 + i * 8192, R, C); const int Rb = Epi::PERM ? ((R & ~31) + perm32(R & 31)) : R;
        voffA[i] = (unsigned)(R * g.lda + C) * 2u; voffB[i] = (unsigned)(Rb * g.ldb + C) * 2u; }
    const size_t kstep = (size_t)(BK * 2);
    const size_t hstepA = (size_t)HALF * g.lda * 2, hstepB = (size_t)HALF * g.ldb * 2;
    const size_t tstepA = 2 * hstepA, tstepB = 2 * hstepB;
    const unsigned ldsw = (unsigned)wid * 1024u;
    const int aoff = lds_byte(wr * 64 + fr, fq * 8), boff = lds_byte(wc * 32 + fr, fq * 8);
#define PG8_SA(b, h) (((b) * 2 + (h)) * HTB)
#define PG8_SB(b, h) ((4 + (b) * 2 + (h)) * HTB)
#define PG8_STAGE(bufoff, gbase, voff) do { _Pragma("unroll") for (int _i = 0; _i < 2; ++_i) \
        __builtin_amdgcn_global_load_lds((const unsigned*)((const char*)(gbase) + (voff)[_i]), (LAS unsigned*)(lds + (bufoff) + ldsw + _i * 8192), 16, 0, 0); } while (0)
#define PG8_LDA(dst, b, h) do { _Pragma("unroll") for (int m = 0; m < 4; ++m) _Pragma("unroll") for (int k = 0; k < 2; ++k) dst[m][k] = *(const LAS bf16x8*)(lds + PG8_SA(b, h) + aoff + m * 2048 + k * 1024); } while (0)
#define PG8_LDB(dst, b, h) do { _Pragma("unroll") for (int n = 0; n < 2; ++n) _Pragma("unroll") for (int k = 0; k < 2; ++k) dst[n][k] = *(const LAS bf16x8*)(lds + PG8_SB(b, h) + boff + n * 2048 + k * 1024); } while (0)
#define PG8_MMA(ai, bj, At, Bt) do { __builtin_amdgcn_s_setprio(1); _Pragma("unroll") for (int m = 0; m < 4; ++m) _Pragma("unroll") for (int n = 0; n < 2; ++n) _Pragma("unroll") for (int k = 0; k < 2; ++k) \
        acc[ai][bj][m][n] = __builtin_amdgcn_mfma_f32_16x16x32_bf16(Bt[n][k], At[m][k], acc[ai][bj][m][n], 0, 0, 0); __builtin_amdgcn_s_setprio(0); } while (0)
#define PG8_WAIT_V(n) asm volatile("s_waitcnt vmcnt(" #n ")" ::: "memory")
#define PG8_WAIT_L(n) asm volatile("s_waitcnt lgkmcnt(" #n ")" ::: "memory")
#define PG8_BAR __builtin_amdgcn_s_barrier()
#define PG8_SCHED __builtin_amdgcn_sched_barrier(0)
    Unit cur, nxt; int ui = 0;
    if (!S.next(0, cur)) return;
    f32x4 acc[2][2][4][2];
#pragma unroll
    for (int a = 0; a < 2; ++a)
#pragma unroll
        for (int b = 0; b < 2; ++b)
#pragma unroll
            for (int m = 0; m < 4; ++m)
#pragma unroll
                for (int n = 0; n < 2; ++n) acc[a][b][m][n] = (f32x4){0.f, 0.f, 0.f, 0.f};
    bf16x8 At[4][2], B0[2][2], B1[2][2];
    const char* cA = (const char*)g.A + (size_t)cur.pm * tstepA; const char* cB = (const char*)g.Bt + (size_t)cur.pn * tstepB;
    S.a_ready(cur);
    if constexpr (SP2) {
        PG8_STAGE(PG8_SB(0, 0), cB, voffB); PG8_STAGE(PG8_SB(0, 1), cB + hstepB, voffB); PG8_STAGE(PG8_SA(0, 0), cA, voffA); PG8_STAGE(PG8_SA(0, 1), cA + hstepA, voffA);
        if (wr == 1) PG8_BAR;
        PG8_WAIT_V(2); PG8_BAR;
        PG8_STAGE(PG8_SB(1, 0), cB + kstep, voffB); PG8_STAGE(PG8_SA(1, 0), cA + kstep, voffA); PG8_STAGE(PG8_SB(1, 1), cB + hstepB + kstep, voffB);
        PG8_WAIT_V(6); PG8_BAR;
    } else {
    PG8_STAGE(PG8_SB(0, 0), cB, voffB); PG8_STAGE(PG8_SA(0, 0), cA, voffA); PG8_STAGE(PG8_SB(0, 1), cB + hstepB, voffB); PG8_STAGE(PG8_SA(0, 1), cA + hstepA, voffA);
    if (wr == 1) PG8_BAR;
    PG8_WAIT_V(4); PG8_BAR;
    PG8_STAGE(PG8_SB(1, 0), cB + kstep, voffB); PG8_STAGE(PG8_SA(1, 0), cA + kstep, voffA); PG8_STAGE(PG8_SB(1, 1), cB + hstepB + kstep, voffB);
    PG8_WAIT_V(6); PG8_BAR;
    }
    for (;;) {
        const bool has_next = S.next(ui + 1, nxt);
        const char* nA = has_next ? (const char*)g.A + (size_t)nxt.pm * tstepA : cA; const char* nB = has_next ? (const char*)g.Bt + (size_t)nxt.pn * tstepB : cB;
        for (int t = 0; t < nt; t += 2) {
            const bool last = (t == nt - 2);
            const char* a1 = cA + (size_t)(t + 1) * kstep;
            const char* a2 = last ? nA : cA + (size_t)(t + 2) * kstep; const char* b2 = last ? nB : cB + (size_t)(t + 2) * kstep;
            const char* a3 = a2 + kstep; const char* b3 = b2 + kstep;
            if (last && has_next) S.a_ready(nxt);
            if constexpr (SP2) {
            PG8_LDB(B0, 0, 0); PG8_LDB(B1, 0, 1); PG8_SCHED; PG8_LDA(At, 0, 0); PG8_STAGE(PG8_SA(1, 1), a1 + hstepA, voffA);
            PG8_WAIT_V(8); PG8_WAIT_L(0); PG8_BAR; PG8_MMA(0, 0, At, B0); PG8_MMA(0, 1, At, B1); PG8_BAR; PG8_SCHED;
            PG8_LDA(At, 0, 1); PG8_STAGE(PG8_SB(0, 0), b2, voffB); PG8_STAGE(PG8_SB(0, 1), b2 + hstepB, voffB); PG8_STAGE(PG8_SA(0, 0), a2, voffA);
            PG8_WAIT_V(8); PG8_WAIT_L(0); PG8_BAR; PG8_MMA(1, 0, At, B0); PG8_MMA(1, 1, At, B1); PG8_BAR; PG8_SCHED;
            PG8_LDB(B0, 1, 0); PG8_LDB(B1, 1, 1); PG8_SCHED; PG8_LDA(At, 1, 0); PG8_STAGE(PG8_SA(0, 1), a2 + hstepA, voffA);
            PG8_WAIT_V(8); PG8_WAIT_L(0); PG8_BAR; PG8_MMA(0, 0, At, B0); PG8_MMA(0, 1, At, B1); PG8_BAR; PG8_SCHED;
            PG8_LDA(At, 1, 1); PG8_STAGE(PG8_SB(1, 0), b3, voffB); PG8_STAGE(PG8_SB(1, 1), b3 + hstepB, voffB); PG8_STAGE(PG8_SA(1, 0), a3, voffA);
            PG8_WAIT_V(8); PG8_WAIT_L(0); PG8_BAR; PG8_MMA(1, 0, At, B0); PG8_MMA(1, 1, At, B1); PG8_BAR; PG8_SCHED;
            } else {
            PG8_LDB(B0, 0, 0); PG8_SCHED; PG8_LDA(At, 0, 0); PG8_STAGE(PG8_SA(1, 1), a1 + hstepA, voffA);
            PG8_WAIT_L(8); PG8_BAR; PG8_WAIT_L(0); PG8_MMA(0, 0, At, B0); PG8_BAR; PG8_SCHED;
            PG8_LDB(B1, 0, 1); PG8_STAGE(PG8_SB(0, 0), b2, voffB);
            PG8_BAR; PG8_WAIT_L(0); PG8_MMA(0, 1, At, B1); PG8_BAR;
            PG8_LDA(At, 0, 1); PG8_STAGE(PG8_SA(0, 0), a2, voffA);
            PG8_BAR; PG8_WAIT_L(0); PG8_MMA(1, 0, At, B0); PG8_BAR; PG8_SCHED;
            PG8_STAGE(PG8_SB(0, 1), b2 + hstepB, voffB);
            PG8_WAIT_V(6); PG8_BAR; PG8_MMA(1, 1, At, B1); PG8_BAR;
            PG8_LDB(B0, 1, 0); PG8_SCHED; PG8_LDA(At, 1, 0); PG8_STAGE(PG8_SA(0, 1), a2 + hstepA, voffA);
            PG8_WAIT_L(8); PG8_BAR; PG8_WAIT_L(0); PG8_MMA(0, 0, At, B0); PG8_BAR; PG8_SCHED;
            PG8_LDB(B1, 1, 1); PG8_STAGE(PG8_SB(1, 0), b3, voffB);
            PG8_BAR; PG8_WAIT_L(0); PG8_MMA(0, 1, At, B1); PG8_BAR;
            PG8_LDA(At, 1, 1); PG8_STAGE(PG8_SA(1, 0), a3, voffA);
            PG8_BAR; PG8_WAIT_L(0); PG8_MMA(1, 0, At, B0); PG8_BAR; PG8_SCHED;
            PG8_STAGE(PG8_SB(1, 1), b3 + hstepB, voffB);
            PG8_WAIT_V(6); PG8_BAR; PG8_MMA(1, 1, At, B1); PG8_BAR;
            }
        }
        if constexpr (ALIGN_EPI) { if (wr == 0) PG8_BAR; }
        E(acc, cur, wr, wc, fr, fq); S.done(cur);
        if (!has_next) break;
#pragma unroll
        for (int a = 0; a < 2; ++a)
#pragma unroll
            for (int b = 0; b < 2; ++b)
#pragma unroll
                for (int m = 0; m < 4; ++m)
#pragma unroll
                    for (int n = 0; n < 2; ++n) acc[a][b][m][n] = (f32x4){0.f, 0.f, 0.f, 0.f};
        cur = nxt; cA = nA; cB = nB; ++ui;
        if constexpr (ALIGN_EPI) { if (wr == 1) PG8_BAR; }
    }
    PG8_WAIT_V(0);
    if constexpr (!ALIGN_EPI) { if (wr == 0) PG8_BAR; }
    PG8_BAR;
#undef PG8_SA
#undef PG8_SB
#undef PG8_STAGE
#undef PG8_LDA
#undef PG8_LDB
#undef PG8_MMA
#undef PG8_WAIT_V
#undef PG8_WAIT_L
#undef PG8_BAR
#undef PG8_SCHED
}
}

struct AttnUnit {
    const bf16_t* Q; int ldq;
    const bf16_t* K; int ldk;
    const bf16_t* Kpe;
    const bf16_t* V; int ldv;
    const bf16_t* G;
    bf16_t* Y;
    int nt, ntreal, nfirst, base1, base2;
    float scale;
    int tq0;
    int ropeq;
    int qnorm, qrope;
    const float* qg;
    const float* rpb;
    const float* tab;
    const float* subln;
    float lam, omli;
};

__host__ __device__ __forceinline__ int attn_nunits(int sect, int rnd) {
    if (rnd == 0) return sect == 2 ? 512 : 256;
    return sect == 0 ? 128 : sect == 1 ? 256 : sect == 2 ? 256 : 0;
}
__device__ __forceinline__ AttnUnit make_unit(int sect, int rnd, int idx, int l, bf16_t* z, bf16_t* qb, bf16_t* kvb, bf16_t* y, const float* a_rpb, const float* tab, const float* subln, const float* cqn) {
    AttnUnit U; U.qnorm = 0; U.qrope = 0; U.qg = cqn + l * 128; U.Kpe = nullptr; U.tq0 = 0; U.ropeq = 0; U.rpb = nullptr; U.tab = tab; U.subln = subln + l * 128; U.lam = tab[TB_LAM + 2 * l]; U.omli = 1.0f - tab[TB_LAM + 2 * l + 1];
    int tok0, kq0, kk0, h, grp, nkeys; bool masked = false;
    if (rnd == 0) {
        int lb, qoff;
        if (sect == 2) { const int q16 = idx & 15; h = (idx >> 4) & 7; lb = idx >> 7; qoff = q16 * 128; } else { const int qblk = idx & 7; h = (idx >> 3) & 7; lb = idx >> 6; qoff = qblk * 256; }
        tok0 = NP + lb * LSEQ + qoff; kk0 = NP + lb * LKV; kq0 = kk0 + qoff; nkeys = LKV; U.tq0 = qoff;
        grp = sect == 0 ? 1 : sect == 1 ? 2 : sect == 2 ? 3 : 0;
        if (sect == 0) U.ropeq = 1;
        if (sect == 3) { masked = true; U.rpb = a_rpb + (size_t)(l * 8 + h) * 465; }
    } else {
        int pb, qoff = 0;
        if (sect == 2) { qoff = (idx & 1) * 128; h = (idx >> 1) & 7; pb = idx >> 4; grp = 3; }
        else if (sect == 0) { h = idx & 7; pb = idx >> 3; grp = 1; }
        else { const int i2 = idx & 127; h = i2 & 7; pb = i2 >> 3; grp = idx < 128 ? 2 : 0; }
        kk0 = pb * 256; tok0 = kk0 + qoff; kq0 = tok0; nkeys = PSEQ;
    }
    const bf16_t* zq = z + (size_t)kq0 * LDZ; const bf16_t* zk = z + (size_t)kk0 * LDZ; bf16_t* yq = y + (size_t)tok0 * DM;
    if (grp == 0) { U.Q = zq + ZC_AQ + h * 128; U.ldq = LDZ; U.K = zk + ZC_AK + h * 128; U.ldk = LDZ; U.V = zk + ZC_AV + h * 128; U.ldv = LDZ; U.scale = 0.08838834764831845f; U.G = zq + ZC_AZ + h * 128; U.Y = yq + h * 128; }
    else if (grp == 1) { U.Q = qb + (size_t)kq0 * LDQB + h * 192; U.ldq = LDQB; U.K = kvb + (size_t)kk0 * LDKVB + h * 256; U.ldk = LDKVB; U.Kpe = zk + ZC_BKPE; U.V = kvb + (size_t)kk0 * LDKVB + h * 256 + 128; U.ldv = LDKVB;
        U.scale = 0.07216878364870323f; U.G = zq + ZC_BZ + h * 128; U.Y = yq + 1024 + h * 128; }
    else if (grp == 2) { U.qnorm = 1; U.qrope = (rnd == 0); U.Q = zq + ZC_CQ + h * 128; U.ldq = LDZ; U.K = zk + ZC_CK + (h >> 2) * 128; U.ldk = LDZ; U.V = zk + ZC_CV + (h >> 2) * 128; U.ldv = LDZ; U.scale = 0.08838834764831845f; U.G = zq + ZC_CZ + h * 128; U.Y = yq + 2048 + h * 128; }
    else { U.qrope = (rnd == 0); U.Q = zq + ZC_DQ + h * 128; U.ldq = LDZ; U.K = zk + ZC_DK + h * 128; U.ldk = LDZ; U.V = zk + ZC_DV + h * 128; U.ldv = LDZ; U.scale = 0.125f; U.G = zq + ZC_DZ + h * 128; U.Y = yq + 3072 + h * 128; }
    if (masked) {
        const int r0 = U.tq0 >> 6; int lo = r0 - 4; lo = lo < 0 ? 0 : (lo > 24 ? 24 : lo); int hs = r0 + 3 - 4; hs = hs < 0 ? 0 : (hs > 24 ? 24 : hs); const int hiR = hs + 7;
        U.ntreal = 4 + (hiR - lo + 1); U.nt = (U.ntreal + 1) & ~1; U.nfirst = 4; U.base1 = 32; U.base2 = lo;
    } else { U.nt = nkeys / 64; U.ntreal = U.nt; U.nfirst = U.nt; U.base1 = 0; U.base2 = 0; }
    return U;
}

namespace att {
constexpr float THR = 8.f;
#define SBAR() __builtin_amdgcn_sched_barrier(0)
__device__ __forceinline__ int crow(int r, int hi) { return (r & 3) + 8 * (r >> 2) + 4 * hi; }
__device__ __forceinline__ float fma1(float a, float b, float c) { float d; asm("v_fma_f32 %0, %1, %2, %3" : "=v"(d) : "v"(a), "v"(b), "v"(c)); return d; }
template <bool FIRST>
__device__ __forceinline__ void partialSM(f32x16& p0, f32x16& p1, float& m_reg, float& alpha, float thr2) {
    float pmax = p0[0];
#pragma unroll
    for (int r = 1; r < 16; ++r) pmax = fmaxf(pmax, p0[r]);
#pragma unroll
    for (int r = 0; r < 16; ++r) pmax = fmaxf(pmax, p1[r]);
    { auto rr = __builtin_amdgcn_permlane32_swap(__float_as_uint(pmax), __float_as_uint(pmax), false, false);
      pmax = fmaxf(__uint_as_float(rr[0]), __uint_as_float(rr[1])); }
    alpha = 1.f;
    if (FIRST || !__all(pmax <= thr2)) {
        const float d = FIRST ? pmax : fmaxf(pmax, 0.f);
        if (!FIRST) alpha = __builtin_amdgcn_exp2f(-d);
        m_reg += d;
#pragma unroll
        for (int r = 0; r < 16; ++r) { p0[r] -= d; p1[r] -= d; }
    }
#pragma unroll
    for (int r = 0; r < 16; ++r) p0[r] = __builtin_amdgcn_exp2f(p0[r]);
}
__device__ __forceinline__ void finishSM(f32x16& p0, f32x16& p1, float alpha, float& l_reg, bf16x8& pa0, bf16x8& pa1, bf16x8& pa2, bf16x8& pa3) {
#pragma unroll
    for (int r = 0; r < 16; ++r) p1[r] = __builtin_amdgcn_exp2f(p1[r]);
    float ps = 0;
#pragma unroll
    for (int r = 0; r < 16; ++r) ps += p0[r];
#pragma unroll
    for (int r = 0; r < 16; ++r) ps += p1[r];
    { auto rr = __builtin_amdgcn_permlane32_swap(__float_as_uint(ps), __float_as_uint(ps), false, false);
      ps = __uint_as_float(rr[0]) + __uint_as_float(rr[1]); }
    l_reg = l_reg * alpha + ps;
#define PK4(P, BASE, OUT) do { u32x4 w = {cvt_pk_bf16(P[BASE + 0], P[BASE + 1]), cvt_pk_bf16(P[BASE + 2], P[BASE + 3]), cvt_pk_bf16(P[BASE + 4], P[BASE + 5]), cvt_pk_bf16(P[BASE + 6], P[BASE + 7])}; \
    OUT = *reinterpret_cast<bf16x8*>(&w); } while (0)
    PK4(p0, 0, pa0); PK4(p0, 8, pa1); PK4(p1, 0, pa2); PK4(p1, 8, pa3);
#undef PK4
}
template <int KW> __device__ __forceinline__ int kswz(int row, int colB) { return row * (KW * 2) + (colB ^ ((row & 7) << 4)); }
template <int OFF> __device__ __forceinline__ bf16x8 lds_rd128(int a) { bf16x8 r; asm volatile("ds_read_b128 %0, %1 offset:%2" : "=&v"(r) : "v"(a), "i"(OFF) : "memory"); return r; }
template <int N> __device__ __forceinline__ void lds_wait2(bf16x8& x, bf16x8& y) { asm volatile("s_waitcnt lgkmcnt(%2)" : "+v"(x), "+v"(y) : "n"(N) : "memory"); }
template <int KW, int KOFF, int D0> __device__ __forceinline__ void qkt_ld(bf16x8& b0, bf16x8& b1, const int (&ka)[4]) {
    constexpr int IMM = (D0 >> 2) * 128 + KOFF;
    b0 = lds_rd128<IMM>(ka[D0 & 3]); b1 = lds_rd128<IMM + 32 * KW * 2>(ka[D0 & 3]);
}
template <int DQ, int KW, int NQR, int KOFF, int D0> __device__ __forceinline__ void qkt_step(f32x16& p0, f32x16& p1, bf16x8 (&kb)[3][2], const int (&ka)[4], const bf16x8* qr, const char* qlds) {
    constexpr int ND0 = DQ / 16;
    if constexpr (D0 < ND0) {
        if constexpr (D0 + 2 < ND0) qkt_ld<KW, KOFF, D0 + 2>(kb[(D0 + 2) % 3][0], kb[(D0 + 2) % 3][1], ka);
        constexpr int AFTER = (ND0 - 1 - D0) < 2 ? (ND0 - 1 - D0) : 2;
        lds_wait2<2 * AFTER>(kb[D0 % 3][0], kb[D0 % 3][1]);
        bf16x8 q; if constexpr (D0 < NQR) q = qr[D0]; else q = *reinterpret_cast<const bf16x8*>(qlds + (D0 - NQR) * 8192);
        p0 = __builtin_amdgcn_mfma_f32_32x32x16_bf16(kb[D0 % 3][0], q, p0, 0, 0, 0);
        p1 = __builtin_amdgcn_mfma_f32_32x32x16_bf16(kb[D0 % 3][1], q, p1, 0, 0, 0);
        qkt_step<DQ, KW, NQR, KOFF, D0 + 1>(p0, p1, kb, ka, qr, qlds);
    }
}
template <int DQ, int KW, int NQR, int KOFF> __device__ __forceinline__ void qkt(f32x16& p0, f32x16& p1, const int (&ka)[4], const bf16x8* qr, const char* qlds, float cinit) {
#pragma unroll
    for (int r = 0; r < 16; ++r) { p0[r] = cinit; p1[r] = cinit; }
    bf16x8 kb[3][2];
    qkt_ld<KW, KOFF, 0>(kb[0][0], kb[0][1], ka); qkt_ld<KW, KOFF, 1>(kb[1][0], kb[1][1], ka);
    qkt_step<DQ, KW, NQR, KOFF, 0>(p0, p1, kb, ka, qr, qlds);
}
__device__ __forceinline__ void rope_pair(bf16x8& a, bf16x8& b, const float* tc, const float* ts) {
    const f32x4 c0 = *(const f32x4*)tc, c1 = *(const f32x4*)(tc + 4), s0 = *(const f32x4*)ts, s1 = *(const f32x4*)(ts + 4);
    const float cs[8] = {c0[0], c0[1], c0[2], c0[3], c1[0], c1[1], c1[2], c1[3]}, sn[8] = {s0[0], s0[1], s0[2], s0[3], s1[0], s1[1], s1[2], s1[3]};
    u32x4 ua = *reinterpret_cast<u32x4*>(&a), ub = *reinterpret_cast<u32x4*>(&b), oa, ob;
#pragma unroll
    for (int w = 0; w < 4; ++w) { const float x1l = bflo(ua[w]), x1h = bfhi(ua[w]), x2l = bflo(ub[w]), x2h = bfhi(ub[w]);
        oa[w] = pk2(x1l * cs[2 * w] - x2l * sn[2 * w], x1h * cs[2 * w + 1] - x2h * sn[2 * w + 1]);
        ob[w] = pk2(x2l * cs[2 * w] + x1l * sn[2 * w], x2h * cs[2 * w + 1] + x1h * sn[2 * w + 1]); }
    a = *reinterpret_cast<bf16x8*>(&oa); b = *reinterpret_cast<bf16x8*>(&ob);
}
__device__ __forceinline__ int v_st(int k, int c) { const int kk = (k & ~0xC) | ((k & 4) << 1) | ((k & 8) >> 1); return ((kk >> 3) * 4 + (c >> 5)) * 512 + ((kk & 7) * 32 + (c & 31)) * 2; }
__device__ __forceinline__ int v_rd_base(int lane) { return ((lane & 3) << 3) | (((lane >> 2) & 3) << 6) | (((lane >> 4) & 1) << 5) | (((lane >> 5) & 1) << 11); }
constexpr int v_rd_off(int d0, int ks, int grp) { return d0 * 512 + ks * 4096 + grp * 256; }
template <int OFF> __device__ __forceinline__ s16x4 tr_read(int vb) {
    s16x4 r; asm volatile("ds_read_b64_tr_b16 %0, %1 offset:%2" : "=&v"(r) : "v"(vb), "i"(OFF) : "memory"); return r;
}
template <int OFF> __device__ __forceinline__ float lds_rd32(int a) { float r; asm volatile("ds_read_b32 %0, %1 offset:%2" : "=&v"(r) : "v"(a), "i"(OFF) : "memory"); return r; }
template <int BASE> __device__ __forceinline__ void maskblk(f32x16& P, int ra, unsigned vm) {
    float b[16];
#define RD_(r) b[r] = lds_rd32<(BASE + ((r) & 3) + 8 * ((r) >> 2)) * 4>(ra);
    RD_(0) RD_(1) RD_(2) RD_(3) RD_(4) RD_(5) RD_(6) RD_(7) RD_(8) RD_(9) RD_(10) RD_(11) RD_(12) RD_(13) RD_(14) RD_(15)
#undef RD_
    asm volatile("s_waitcnt lgkmcnt(0)" : "+v"(b[0]), "+v"(b[1]), "+v"(b[2]), "+v"(b[3]), "+v"(b[4]), "+v"(b[5]), "+v"(b[6]), "+v"(b[7]), "+v"(b[8]), "+v"(b[9]), "+v"(b[10]), "+v"(b[11]), "+v"(b[12]), "+v"(b[13]), "+v"(b[14]), "+v"(b[15]) :: "memory");
#pragma unroll
    for (int r = 0; r < 16; ++r) P[r] = ((vm >> r) & 1u) ? P[r] + b[r] : -1e30f;
}
template <int D0> __device__ __forceinline__ void pv_one(f32x16& od, int vb, bf16x8 pa0, bf16x8 pa1, bf16x8 pa2, bf16x8 pa3) {
    s16x4 l0 = tr_read<v_rd_off(D0, 0, 0)>(vb), h0 = tr_read<v_rd_off(D0, 0, 1)>(vb), l1 = tr_read<v_rd_off(D0, 1, 0)>(vb), h1 = tr_read<v_rd_off(D0, 1, 1)>(vb);
    s16x4 l2 = tr_read<v_rd_off(D0, 2, 0)>(vb), h2 = tr_read<v_rd_off(D0, 2, 1)>(vb), l3 = tr_read<v_rd_off(D0, 3, 0)>(vb), h3 = tr_read<v_rd_off(D0, 3, 1)>(vb);
    asm volatile("s_waitcnt lgkmcnt(0)" : "+v"(l0), "+v"(h0), "+v"(l1), "+v"(h1), "+v"(l2), "+v"(h2), "+v"(l3), "+v"(h3) :: "memory");
#define PK(L, H) (bf16x8){L[0], L[1], L[2], L[3], H[0], H[1], H[2], H[3]}
    od = __builtin_amdgcn_mfma_f32_32x32x16_bf16(PK(l0, h0), pa0, od, 0, 0, 0);
    od = __builtin_amdgcn_mfma_f32_32x32x16_bf16(PK(l1, h1), pa1, od, 0, 0, 0);
    od = __builtin_amdgcn_mfma_f32_32x32x16_bf16(PK(l2, h2), pa2, od, 0, 0, 0);
    od = __builtin_amdgcn_mfma_f32_32x32x16_bf16(PK(l3, h3), pa3, od, 0, 0, 0);
#undef PK
}
__device__ __forceinline__ void pv_d0(f32x16* o, int vb, bf16x8 pa0, bf16x8 pa1, bf16x8 pa2, bf16x8 pa3) {
    pv_one<0>(o[0], vb, pa0, pa1, pa2, pa3); pv_one<1>(o[1], vb, pa0, pa1, pa2, pa3); pv_one<2>(o[2], vb, pa0, pa1, pa2, pa3); pv_one<3>(o[3], vb, pa0, pa1, pa2, pa3);
}

struct SectCtx { int sect, rnd, l, nu; unsigned* qc; bf16_t* z; bf16_t* qb; bf16_t* kvb; bf16_t* y; const float* a_rpb; const float* tab; const float* subln; const float* cqn; };
struct StOff { int vo0, vts, v32, ko0, k32, ktsn; };
template <int DQ, int KW, bool MASK, bool DPAIR>
__device__ __forceinline__ void attn_section(const SectCtx& C, char* lds, int wv) {
    constexpr int SHM_V = 16384, SHM_K = 64 * KW * 2, ND0 = DQ / 16, NKC = KW / 64, SD = 1;
    int lane_ = lane_id(); asm volatile("" : "+v"(lane_));
    const int wid = wv, lane = lane_, tid = wid * 64 + lane, r32 = lane & 31, hi = lane >> 5;
    const int sub = DPAIR ? (wid >> 2) : 0, rowbase = DPAIR ? (wid & 3) * 32 : wid * 32, cofs = sub * 128;
    const bool leader = (wid == 0) && (lane == 0);
    constexpr bool V3 = (KW != 192) && !MASK;
    constexpr int NVB = V3 ? 3 : 2;
    char* V_lds = lds; char* K_lds = lds + NVB * SHM_V;
    constexpr int WSF_OFF = ATT_WSF_OFF, RPB_OFF = ATT_RPB_OFF, QL_OFF = NVB * SHM_V + 2 * SHM_K;
    constexpr int GT_ROWB = 272, GT_OFF = DPAIR ? 65536 : 0, GCH = DPAIR ? 4 : 8;
        float* rpb_l = (float*)(lds + RPB_OFF);
    volatile unsigned* MQ = (volatile unsigned*)(lds + MISC_OFF);
    constexpr int NQR = DQ == 192 ? 6 : ND0;
    const char* qlds = lds + QL_OFF + tid * 16;
    const int sr = tid >> 4, sc = (tid & 15) * 8, vst0 = v_st(sr, sc);
    const int kst0 = kswz<KW>(sr, sc * 2);
    const int kop = (tid >> 3) * LDZ + (tid & 7) * 8, kstp = kswz<KW>(tid >> 3, (16 + (tid & 7)) * 16), ktsp = 64 * LDZ;
    (void)kop; (void)kstp; (void)ktsp;
    const int vb0 = (int)(uintptr_t)V_lds + v_rd_base(lane);
    int ka[4];
#pragma unroll
    for (int i = 0; i < 4; ++i) ka[i] = (int)(uintptr_t)K_lds + r32 * (KW * 2) + cofs + ((i * 32 + hi * 16) ^ ((r32 & 7) << 4));
    struct Slot { bf16x8 vs0, vs1, ks[NKC]; } sl[SD];
#define MKOFF(UU) StOff{sr * (UU).ldv + sc, 64 * (UU).ldv, 32 * (UU).ldv, sr * (UU).ldk + sc, 32 * (UU).ldk, 64 * (UU).ldk}
#define KT_OFX(UU, j) ((j) < (UU).nfirst ? (UU).base1 + (j) : (UU).base2 + (j) - (UU).nfirst)
#define SLOADX(UU, OF, i, j) do { const int kt_ = KT_OFX(UU, j); sl[i].vs0 = *reinterpret_cast<const bf16x8*>((UU).V + ((OF).vo0 + kt_ * (OF).vts)); sl[i].vs1 = *reinterpret_cast<const bf16x8*>((UU).V + ((OF).vo0 + (kt_ * (OF).vts + (OF).v32))); \
    if constexpr (KW >= 128) { sl[i].ks[0] = *reinterpret_cast<const bf16x8*>((UU).K + ((OF).ko0 + kt_ * (OF).ktsn)); sl[i].ks[1] = *reinterpret_cast<const bf16x8*>((UU).K + ((OF).ko0 + (kt_ * (OF).ktsn + (OF).k32))); } \
    if constexpr (KW == 192) sl[i].ks[2] = *reinterpret_cast<const bf16x8*>((UU).Kpe + (kop + kt_ * ktsp)); } while (0)
#define QLOADX(UU, R32_, HI_) do { const bf16_t* Qw_ = (UU).Q + ((rowbase + (R32_)) * (UU).ldq + sub * 64 + (HI_) * 8); \
    _Pragma("unroll") for (int d0 = 0; d0 < ND0; ++d0) qr[d0] = *reinterpret_cast<const bf16x8*>(Qw_ + d0 * 16); \
    if constexpr (MASK) { if (tid < 465) p_rpb = (UU).rpb[tid]; } } while (0)
#define KT_OF(j) KT_OFX(U, j)
#define SLOAD(i, j) SLOADX(U, of, i, j)
#define SWRITE(b, vo, i) do { *(bf16x8*)(V_lds + (vo) + vst0) = sl[i].vs0; *(bf16x8*)(V_lds + (vo) + vst0 + 8192) = sl[i].vs1; \
    *(bf16x8*)(K_lds + (b) * SHM_K + kst0) = sl[i].ks[0]; *(bf16x8*)(K_lds + (b) * SHM_K + kst0 + 32 * KW * 2) = sl[i].ks[1]; \
    if constexpr (KW == 192) *(bf16x8*)(K_lds + (b) * SHM_K + kstp) = sl[i].ks[2]; } while (0)
#define SWAIT() asm volatile("s_waitcnt vmcnt(0)" ::: "memory")
#define RESC(a) do { if (__any((a) < 1.f)) { _Pragma("unroll") for (int d = 0; d < 4; ++d) _Pragma("unroll") for (int r = 0; r < 16; ++r) o[d][r] *= (a); } } while (0)
#define MASKB(P0, P1, j) do { if constexpr (MASK) { const int kt_ = KT_OF(j); \
    if ((j) >= U.ntreal || (kt_ < 32 && (kt_ < srw || kt_ > srw + 7))) { _Pragma("unroll") for (int r = 0; r < 16; ++r) { P0[r] = -1e30f; P1[r] = -1e30f; } } \
    else if (kt_ < 32) { const int ra_ = (int)(uintptr_t)rpb_l + ((kt_ - qrw + 7) * 31 + 15 - qc + 4 * hi) * 4;     \
        maskblk<0>(P0, ra_, vm0); maskblk<32>(P1, ra_, vm1); } } } while (0)
#define MKUNIT(idx_) make_unit(C.sect, C.rnd, (idx_), C.l, C.z, C.qb, C.kvb, C.y, C.a_rpb, C.tab, C.subln, C.cqn)
    if (leader) MQ[16] = atomicAdd(C.qc, 1u);
    __syncthreads(); const int idx0 = __builtin_amdgcn_readfirstlane((int)MQ[16]); __syncthreads();
    if (idx0 >= C.nu) return;
    AttnUnit U = MKUNIT(idx0); StOff of = MKOFF(U);
    bf16x8 qr[ND0]; float p_rpb = 0.f;
    QLOADX(U, r32, hi); SLOADX(U, of, 0, 0);
    for (;;) {
        unsigned r_next = 0u; if (leader) r_next = atomicAdd(C.qc, 1u);
        const float Cc = U.scale * 1.4426950408889634f, thr2 = THR * 1.4426950408889634f;
        float m_reg = 0.f, l_reg = 0; f32x16 o[4] = {};
#define QSCALE() do { _Pragma("unroll") for (int d0 = 0; d0 < ND0; ++d0) { u32x4 w_ = *reinterpret_cast<u32x4*>(&qr[d0]); \
            w_.x = cvt_pk_bf16(bflo(w_.x) * Cc, bfhi(w_.x) * Cc); w_.y = cvt_pk_bf16(bflo(w_.y) * Cc, bfhi(w_.y) * Cc); w_.z = cvt_pk_bf16(bflo(w_.z) * Cc, bfhi(w_.z) * Cc); w_.w = cvt_pk_bf16(bflo(w_.w) * Cc, bfhi(w_.w) * Cc); \
            qr[d0] = *reinterpret_cast<bf16x8*>(&w_); } } while (0)
        if constexpr (DQ == 192) {
            if (U.ropeq) { const int t = U.tq0 + rowbase + r32, prow = t >> 6, pcol = t & 63;
                rope_pair(qr[8], qr[9], U.tab + TB_C64 + prow * 16 + hi * 8, U.tab + TB_S64 + prow * 16 + hi * 8);
                rope_pair(qr[10], qr[11], U.tab + TB_C64 + pcol * 16 + hi * 8, U.tab + TB_S64 + pcol * 16 + hi * 8); }
            QSCALE();
            char* qw = lds + QL_OFF + tid * 16;
#pragma unroll
            for (int d0 = NQR; d0 < ND0; ++d0) *(bf16x8*)(qw + (d0 - NQR) * 8192) = qr[d0];
        }
        if constexpr (DQ == 128 && !MASK && !DPAIR) {
            if (U.qnorm) { int h8 = hi * 8; asm volatile("" : "+v"(h8));
                float xf[8][8]; float ss = 0.f;
#pragma unroll
                for (int d0 = 0; d0 < 8; ++d0) { const u32x4 w = *reinterpret_cast<const u32x4*>(&qr[d0]);
                    xf[d0][0] = bflo(w.x); xf[d0][1] = bfhi(w.x); xf[d0][2] = bflo(w.y); xf[d0][3] = bfhi(w.y); xf[d0][4] = bflo(w.z); xf[d0][5] = bfhi(w.z); xf[d0][6] = bflo(w.w); xf[d0][7] = bfhi(w.w);
#pragma unroll
                    for (int e = 0; e < 8; ++e) ss += xf[d0][e] * xf[d0][e]; }
                { auto rr = __builtin_amdgcn_permlane32_swap(__float_as_uint(ss), __float_as_uint(ss), false, false); ss = __uint_as_float(rr[0]) + __uint_as_float(rr[1]); }
                const float rstd = 1.0f / sqrtf(ss * (1.0f / 128.0f) + EPS);
#pragma unroll
                for (int d0 = 0; d0 < 8; ++d0) { const f32x4 g0 = *(const f32x4*)(U.qg + d0 * 16 + h8), g1 = *(const f32x4*)(U.qg + d0 * 16 + h8 + 4);
#pragma unroll
                    for (int e = 0; e < 4; ++e) { xf[d0][e] = xf[d0][e] * rstd * g0[e]; xf[d0][4 + e] = xf[d0][4 + e] * rstd * g1[e]; } }
                if (U.qrope) { const int t = U.tq0 + rowbase + r32, prow = t >> 6, pcol = t & 63;
#pragma unroll
                    for (int pr = 0; pr < 4; ++pr) { const int da = (pr >> 1) * 4 + (pr & 1), db = da + 2, pos = pr < 2 ? prow : pcol, fb = (pr & 1) * 16 + h8;
                        const f32x4 c0 = *(const f32x4*)(U.tab + TB_C128 + pos * 32 + fb), c1 = *(const f32x4*)(U.tab + TB_C128 + pos * 32 + fb + 4), s0 = *(const f32x4*)(U.tab + TB_S128 + pos * 32 + fb), s1 = *(const f32x4*)(U.tab + TB_S128 + pos * 32 + fb + 4);
#pragma unroll
                        for (int e = 0; e < 8; ++e) { const float cs = e < 4 ? c0[e & 3] : c1[e & 3], sn = e < 4 ? s0[e & 3] : s1[e & 3]; const float x1 = xf[da][e], x2 = xf[db][e];
                            xf[da][e] = x1 * cs - x2 * sn; xf[db][e] = x2 * cs + x1 * sn; } } }
#pragma unroll
                for (int d0 = 0; d0 < 8; ++d0) { u32x4 w; w.x = pk2(xf[d0][0], xf[d0][1]); w.y = pk2(xf[d0][2], xf[d0][3]); w.z = pk2(xf[d0][4], xf[d0][5]); w.w = pk2(xf[d0][6], xf[d0][7]); qr[d0] = *reinterpret_cast<bf16x8*>(&w); }
            }
        }
        if constexpr (DPAIR) {
            if (U.qrope) { const int t = U.tq0 + rowbase + r32, prow = t >> 6, pcol = t & 63;
                rope_pair(qr[0], qr[1], U.tab + TB_C64 + prow * 16 + hi * 8, U.tab + TB_S64 + prow * 16 + hi * 8);
                rope_pair(qr[2], qr[3], U.tab + TB_C64 + pcol * 16 + hi * 8, U.tab + TB_S64 + pcol * 16 + hi * 8); }
        }
        if constexpr (DQ != 192) QSCALE();
#undef QSCALE
        int qrw = 0, srw = 0, qc = 0; unsigned vm0 = 0, vm1 = 0;
        if constexpr (MASK) {
            qrw = (U.tq0 >> 6) + (wid >> 1); srw = qrw - 4; srw = srw < 0 ? 0 : (srw > 24 ? 24 : srw);
            qc = 32 * (wid & 1) + r32; int scq = qc - 8; scq = scq < 0 ? 0 : (scq > 48 ? 48 : scq);
#pragma unroll
            for (int r = 0; r < 16; ++r) { const int k0 = crow(r, hi), k1 = 32 + k0; vm0 |= (unsigned)(k0 >= scq && k0 < scq + 16) << r; vm1 |= (unsigned)(k1 >= scq && k1 < scq + 16) << r; }
            if (tid < 465) rpb_l[tid] = p_rpb * 1.4426950408889634f;
        }
        f32x16 pA0, pA1, pB0, pB1; float alA, alB; bf16x8 pa0, pa1, pa2, pa3; const int NT = U.nt;
        SWRITE(0, 0, 0); SLOAD(0, 1); __syncthreads();
        qkt<DQ, KW, NQR, 0>(pA0, pA1, ka, qr, qlds, 0.f); MASKB(pA0, pA1, 0); partialSM<true>(pA0, pA1, m_reg, alA, thr2);
        SWAIT(); if (leader) MQ[17] = r_next; SWRITE(1, SHM_V, 0); __syncthreads();
        int v0 = 0;
#define VNX(v) (V3 ? ((v) + SHM_V == 3 * SHM_V ? 0 : (v) + SHM_V) : ((v) ^ SHM_V))
        for (int j = 1; j + 1 < NT; j += 2) {
            SBAR(); SLOAD(0, j + 1); SBAR();
            qkt<DQ, KW, NQR, SHM_K>(pB0, pB1, ka, qr, qlds, -m_reg);
            finishSM(pA0, pA1, alA, l_reg, pa0, pa1, pa2, pa3); SBAR();
            pv_d0(o, vb0 + v0, pa0, pa1, pa2, pa3); MASKB(pB0, pB1, j); partialSM<false>(pB0, pB1, m_reg, alB, thr2);
            if constexpr (!V3) __syncthreads();
            SWAIT(); SWRITE(0, (V3 ? VNX(VNX(v0)) : v0), 0);
            RESC(alB); __syncthreads();
            SBAR(); SLOAD(0, j + 2); SBAR();
            qkt<DQ, KW, NQR, 0>(pA0, pA1, ka, qr, qlds, -m_reg);
            finishSM(pB0, pB1, alB, l_reg, pa0, pa1, pa2, pa3); SBAR();
            pv_d0(o, vb0 + VNX(v0), pa0, pa1, pa2, pa3); MASKB(pA0, pA1, j + 1); partialSM<false>(pA0, pA1, m_reg, alA, thr2);
            if constexpr (!V3) __syncthreads();
            SWAIT(); SWRITE(1, (V3 ? v0 : VNX(v0)), 0);
            RESC(alA); __syncthreads();
            if constexpr (V3) v0 = VNX(VNX(v0));
        }
        bf16x8 gch[GCH];
        SBAR(); qkt<DQ, KW, NQR, SHM_K>(pB0, pB1, ka, qr, qlds, -m_reg);
        finishSM(pA0, pA1, alA, l_reg, pa0, pa1, pa2, pa3); SBAR();
        pv_d0(o, vb0 + v0, pa0, pa1, pa2, pa3); MASKB(pB0, pB1, NT - 1); partialSM<false>(pB0, pB1, m_reg, alB, thr2);
        RESC(alB);
        finishSM(pB0, pB1, alB, l_reg, pa0, pa1, pa2, pa3); SBAR();
        pv_d0(o, vb0 + VNX(v0), pa0, pa1, pa2, pa3);
        int tide = tid; asm volatile("" : "+v"(tide));
        const int g_off = (tide >> 4) * LDZ + (tide & 15) * 8, t_off = GT_OFF + (tide >> 4) * GT_ROWB + (tide & 15) * 16;
#pragma unroll
        for (int i = 0; i < GCH; ++i) gch[i] = *reinterpret_cast<const bf16x8*>(U.G + (g_off + i * 32 * LDZ));
        const int nidx = __builtin_amdgcn_readfirstlane((int)MQ[17]); const bool has_next = nidx < C.nu;
        AttnUnit Un = U; StOff ofn = of;
        if (has_next) { Un = MKUNIT(nidx); ofn = MKOFF(Un); }
        QLOADX(Un, tide & 31, (tide >> 5) & 1); SLOADX(Un, ofn, 0, 0);
        SBAR();
        { const float rl = __builtin_amdgcn_rcpf(l_reg);
#pragma unroll
          for (int d0 = 0; d0 < 4; ++d0)
#pragma unroll
              for (int r = 0; r < 16; ++r) o[d0][r] *= rl; }
        __syncthreads();
        char* tl = lds + ((rowbase + r32) * GT_ROWB + GT_OFF + hi * 8);
        if constexpr (!DPAIR) {
#pragma unroll
            for (int i = 0; i < GCH; ++i) *(bf16x8*)(lds + t_off + i * 32 * GT_ROWB) = gch[i];
            __syncthreads();
#pragma unroll
            for (int d0 = 0; d0 < 4; ++d0)
#pragma unroll
                for (int rg = 0; rg < 4; ++rg) { u32x2* p = (u32x2*)(tl + d0 * 64 + rg * 16); const u32x2 g = *p; u32x2 w;
                    w.x = cvt_pk_bf16(o[d0][4 * rg] * silu_f(bflo(g.x)), o[d0][4 * rg + 1] * silu_f(bfhi(g.x))); w.y = cvt_pk_bf16(o[d0][4 * rg + 2] * silu_f(bflo(g.y)), o[d0][4 * rg + 3] * silu_f(bfhi(g.y))); *p = w; }
        } else {
            float* xch = (float*)lds + ((wid & 3) * 64 + lane);
            if (sub == 1) {
#pragma unroll
                for (int d0 = 0; d0 < 4; ++d0)
#pragma unroll
                    for (int r = 0; r < 16; ++r) xch[(d0 * 16 + r) * 256] = o[d0][r];
            }
#pragma unroll
            for (int i = 0; i < GCH; ++i) *(bf16x8*)(lds + t_off + i * 32 * GT_ROWB) = gch[i];
            __syncthreads();
            if (sub == 0) {
                const float lam = U.lam; float ss = 0.f;
#pragma unroll
                for (int d0 = 0; d0 < 4; ++d0)
#pragma unroll
                    for (int r = 0; r < 16; ++r) { const float od = o[d0][r] - lam * xch[(d0 * 16 + r) * 256]; o[d0][r] = od; ss += od * od; }
                { auto rr = __builtin_amdgcn_permlane32_swap(__float_as_uint(ss), __float_as_uint(ss), false, false); ss = __uint_as_float(rr[0]) + __uint_as_float(rr[1]); }
                const float rstd = U.omli / sqrtf(ss * (1.0f / 128.0f) + EPS);
                const float* gsl = U.subln + hi * 4;
#pragma unroll
                for (int d0 = 0; d0 < 4; ++d0)
#pragma unroll
                    for (int rg = 0; rg < 4; ++rg) { u32x2* p = (u32x2*)(tl + d0 * 64 + rg * 16); const u32x2 g = *p; const f32x4 gl = *(const f32x4*)(gsl + d0 * 32 + rg * 8); u32x2 w;
                        w.x = cvt_pk_bf16(o[d0][4 * rg] * rstd * gl[0] * silu_f(bflo(g.x)), o[d0][4 * rg + 1] * rstd * gl[1] * silu_f(bfhi(g.x)));
                        w.y = cvt_pk_bf16(o[d0][4 * rg + 2] * rstd * gl[2] * silu_f(bflo(g.y)), o[d0][4 * rg + 3] * rstd * gl[3] * silu_f(bfhi(g.y))); *p = w; }
            }
        }
        __syncthreads();
        { bf16_t* yb = U.Y + ((tide >> 4) * DM + (tide & 15) * 8);
#pragma unroll
          for (int i = 0; i < GCH; ++i) *reinterpret_cast<bf16x8*>(yb + i * 32 * DM) = *(const bf16x8*)(lds + t_off + i * 32 * GT_ROWB); }
        __syncthreads();
        if (!has_next) break;
        U = Un; of = ofn;
    }
#undef MKOFF
#undef KT_OFX
#undef SLOADX
#undef QLOADX
#undef KT_OF
#undef SLOAD
#undef SWRITE
#undef VNX
#undef SWAIT
#undef RESC
#undef MASKB
#undef MKUNIT
}
}

#define XB_TMO      128
#define XB_XCNT(j)  (256  + 64 * (j))
#define XB_XSUB(j)  (1280 + 64 * (j))
#define XB_XGEN(j)  (2304 + 64 * (j))
#define XB_TOP      3328
#define XB_TOPGEN   3392
#define XCD_BAR_WORDS 3456
#define XB_SPIN_CAP (1u << 22)
__device__ __forceinline__ unsigned xb_ld(unsigned* p)              { return __hip_atomic_load(p, __ATOMIC_RELAXED, __HIP_MEMORY_SCOPE_AGENT); }
__device__ __forceinline__ unsigned xb_add(unsigned* p, unsigned v) { return __hip_atomic_fetch_add(p, v, __ATOMIC_RELAXED, __HIP_MEMORY_SCOPE_AGENT); }
__device__ __forceinline__ unsigned xb_xcc_id() { return (unsigned)__builtin_amdgcn_s_getreg((3 << 11) | 20) & 0xFu; }
#define XB_SPIN(cond, bar) do { unsigned _sp = 0; while (cond) { __builtin_amdgcn_s_sleep(1); \
    if ((++_sp & 255u) == 0u) { if (xb_ld(&(bar)[XB_TMO])) break; if (_sp > XB_SPIN_CAP) { atomicAdd(&(bar)[XB_TMO], 1u); break; } } } } while (0)
struct XcdBarrier { unsigned* bar; unsigned x; volatile LAS unsigned* st; };
__device__ __forceinline__ XcdBarrier xcd_barrier_post(unsigned* bar, volatile LAS unsigned* st, bool leader) {
    XcdBarrier b; b.bar = bar; b.x = xb_xcc_id(); b.st = st;
    if (leader) (void)xb_add(&bar[XB_XCNT(b.x)], 1u);
    return b;
}
__device__ __forceinline__ void xcd_barrier_complete(unsigned* bar, unsigned x, unsigned& nloc, unsigned& nx) {
    const unsigned G = gridDim.x * gridDim.y * gridDim.z;
    unsigned sum, cnt, mine, sp = 0u;
    for (;;) {
        sum = 0u; cnt = 0u; mine = 0u;
#pragma unroll
        for (unsigned j = 0; j < 16; ++j) { const unsigned c = xb_ld(&bar[XB_XCNT(j)]); sum += c; cnt += (c > 0u) ? 1u : 0u; mine = (j == x) ? c : mine; }
        if (sum == G) break;
        __builtin_amdgcn_s_sleep(1);
        if ((++sp & 255u) == 0u) { if (xb_ld(&bar[XB_TMO])) break; if (sp > XB_SPIN_CAP) { atomicAdd(&bar[XB_TMO], 1u); break; } }
    }
    nloc = mine > 0u ? mine : 1u; nx = cnt > 0u ? cnt : 1u;
}
__device__ __forceinline__ void xcd_barrier(const XcdBarrier& b, bool leader) {
    asm volatile("s_waitcnt vmcnt(0)" ::: "memory");
    __syncthreads();
    if (leader) {
        unsigned* bar = b.bar; asm volatile("" : "+s"(bar)); bar = GLOBAL_PTR(unsigned, bar);
        const unsigned bx = xb_xcc_id();
        __builtin_amdgcn_s_waitcnt(0);
        unsigned nloc = b.st[0], nx = b.st[1];
        if (nloc == 0u) { xcd_barrier_complete(bar, bx, nloc, nx); b.st[0] = nloc; b.st[1] = nx; }
        const unsigned old = xb_add(&bar[XB_XSUB(bx)], 1u);
        const unsigned gen = old / nloc;
        if (old + 1u == (gen + 1u) * nloc) {
            __builtin_amdgcn_fence(__ATOMIC_RELEASE, "agent");
            asm volatile("s_waitcnt vmcnt(0)" ::: "memory");
            const unsigned og = xb_add(&bar[XB_TOP], 1u);
            const unsigned tg = og / nx;
            if (og + 1u == (tg + 1u) * nx) xb_add(&bar[XB_TOPGEN], 1u);
            else XB_SPIN(xb_ld(&bar[XB_TOPGEN]) == tg, bar);
            __builtin_amdgcn_fence(__ATOMIC_ACQUIRE, "agent");
            xb_add(&bar[XB_XGEN(bx)], 1u);
            asm volatile("s_waitcnt vmcnt(0)" ::: "memory");
        } else {
            XB_SPIN(xb_ld(&bar[XB_XGEN(bx)]) == gen, bar);
            __builtin_amdgcn_fence(__ATOMIC_ACQUIRE, "agent");
            asm volatile("s_waitcnt vmcnt(0)" ::: "memory");
        }
    }
    __syncthreads();
}

struct Params { const float* in[30]; float* out; unsigned char* ws; int ph_lo, ph_hi; };
#define PIN(i) GLOBAL_PTR(const float, P.in[i])
typedef const __attribute__((address_space(4))) Params* KargPtr;
#define KARGS_P() KargPtr kp_ = (KargPtr)__builtin_amdgcn_kernarg_segment_ptr(); asm volatile("" : "+s"(kp_)); const __attribute__((address_space(4))) Params& P = *kp_
enum { I_XP = 0, I_XS, I_CAK, I_CAV, I_CBCKV, I_CBKPE, I_CCK, I_CCV, I_CDK, I_CDV, I_C, I_CCTX, I_NORMG, I_WADA, I_BADA, I_WIN, I_WOUT, I_RPB, I_BQN, I_WUQ, I_BKVN, I_WUKV,
       I_CQN, I_CKN, I_LQ1, I_LK1, I_LQ2, I_LK2, I_SUBLN, I_FNG };

__device__ __forceinline__ void transpose_item(const float* __restrict__ W, int ldw, int k0, int nsrc0, bf16_t* __restrict__ WT, int K, int ndst0, LAS unsigned* scr, int lane, const float* kg = nullptr) {
    const int kk = lane >> 4, n4 = (lane & 15) * 4;
    const float* src = W + (size_t)(k0 + 2 * kk) * ldw + nsrc0 + n4;
    f32x4 a[8], b[8];
#pragma unroll
    for (int i = 0; i < 8; ++i) { a[i] = __builtin_nontemporal_load((const f32x4*)(src + (size_t)(8 * i) * ldw)); b[i] = __builtin_nontemporal_load((const f32x4*)(src + (size_t)(8 * i + 1) * ldw)); }
    if (kg) {
#pragma unroll
        for (int i = 0; i < 8; ++i) { a[i] = a[i] * kg[k0 + 2 * kk + 8 * i]; b[i] = b[i] * kg[k0 + 2 * kk + 8 * i + 1]; } }
#pragma unroll
    for (int i = 0; i < 8; ++i) { u32x4 w; w.x = pk2(a[i][0], b[i][0]); w.y = pk2(a[i][1], b[i][1]); w.z = pk2(a[i][2], b[i][2]); w.w = pk2(a[i][3], b[i][3]);
        *(LAS u32x4*)(scr + (i * 4 + kk) * 68 + n4) = w; }
    LDS_WAIT(); asm volatile("" ::: "memory");
    const int kp4 = (lane & 7) * 4;
#pragma unroll
    for (int j = 0; j < 8; ++j) { const int n = (lane >> 3) + 8 * j; const LAS unsigned* sp = scr + kp4 * 68 + n;
        u32x4 o; o.x = sp[0]; o.y = sp[68]; o.z = sp[136]; o.w = sp[204];
        *(u32x4*)(WT + (size_t)(ndst0 + n) * K + k0 + kp4 * 2) = o; }
    LDS_WAIT(); asm volatile("" ::: "memory");
}

#define PH_WS() unsigned char* ws = P.ws; asm volatile("" : "+s"(ws)); ws = GLOBAL_PTR(unsigned char, ws)
#define PH_KWS() KARGS_P(); PH_WS()
#define PH_IDS() int lane_ = lane_id(); asm volatile("" : "+v"(lane_)); const int lane = lane_, wave = wv, NGW = gridDim.x * NWAVES, gw = blockIdx.x * NWAVES + wave; (void)wave
__device__ __forceinline__ void ph_prologue(LAS unsigned char* lds, bool gemv, int wv) {
    KARGS_P(); PH_IDS(); PH_WS();
    if (gemv) for (int it = blockIdx.x; it < 256; it += gridDim.x) {
        const int l = it >> 7, rch = (it >> 4) & 7, cb = it & 15, dch = rch * 8 + wave;
        LAS float* sv = (LAS float*)(lds + wave * 2048);
        LAS float* accl = (LAS float*)(lds + 16384);
        for (int i = wave * 64 + lane; i < 3840; i += NTHR) accl[i] = 0.f;
        { const int d = dch * 64 + lane; sv[lane * 8] = silu_f(PIN(I_CCTX)[d]);
#pragma unroll
          for (int v = 1; v < 5; ++v) sv[lane * 8 + v] = silu_f(PIN(I_C)[(v - 1) * DM + d]); }
        __syncthreads();
        const float* W = PIN(I_WADA) + (size_t)l * DM * 12288 + (size_t)(dch * 64) * 12288 + cb * 768 + lane * 4;
        f32x4 acc[5][3];
#pragma unroll
        for (int v = 0; v < 5; ++v)
#pragma unroll
            for (int j = 0; j < 3; ++j) acc[v][j] = (f32x4){0.f, 0.f, 0.f, 0.f};
        for (int r0 = 0; r0 < 64; r0 += 8) {
            f32x4 w[8][3];
#pragma unroll
            for (int rr = 0; rr < 8; ++rr)
#pragma unroll
                for (int j = 0; j < 3; ++j) w[rr][j] = __builtin_nontemporal_load((const f32x4*)(W + (size_t)(r0 + rr) * 12288 + j * 256));
            __builtin_amdgcn_sched_barrier(0);
#pragma unroll
            for (int rr = 0; rr < 8; ++rr) { const f32x4 s0 = *(const LAS f32x4*)(sv + (r0 + rr) * 8); const float s4 = sv[(r0 + rr) * 8 + 4];
#pragma unroll
                for (int j = 0; j < 3; ++j) { acc[0][j] += w[rr][j] * s0[0]; acc[1][j] += w[rr][j] * s0[1]; acc[2][j] += w[rr][j] * s0[2]; acc[3][j] += w[rr][j] * s0[3]; acc[4][j] += w[rr][j] * s4; } }
        }
#pragma unroll
        for (int v = 0; v < 5; ++v)
#pragma unroll
            for (int j = 0; j < 3; ++j)
#pragma unroll
                for (int c = 0; c < 4; ++c) __hip_atomic_fetch_add(accl + v * 768 + j * 256 + lane * 4 + c, acc[v][j][c], __ATOMIC_RELAXED, __HIP_MEMORY_SCOPE_WORKGROUP);
        __syncthreads();
        float* mod = (float*)(ws + WS_CTL + CTL_MOD) + (size_t)l * 5 * 12288;
        for (int i = wave * 64 + lane; i < 3840; i += NTHR) { const int v = i / 768, c = i - v * 768; float val = accl[i];
            if (rch == 0) val += PIN(I_BADA)[(size_t)l * 12288 + cb * 768 + c];
            atomicAdd(mod + (size_t)v * 12288 + cb * 768 + c, val); }
        __syncthreads();
    }
    if (PROBE_T && blockIdx.x == 0 && wave == 0 && lane == 0) { volatile LAS unsigned* M_ = (volatile LAS unsigned*)(lds + MISC_OFF); asm volatile("s_waitcnt vmcnt(0)" ::: "memory"); const unsigned long long r_ = wall_clock64(); M_[64 + 30] = (unsigned)r_; M_[65 + 30] = (unsigned)(r_ >> 32); }
    if (gw == NGW - 1) {
        float* tab = (float*)(ws + WS_TAB);
        for (int i = lane; i < 1024; i += 64) { const int pos = i >> 4, j = i & 15; const float fr = powf(10000.0f, -(float)j / 16.0f), a = (float)pos * fr; tab[TB_C64 + i] = cosf(a); tab[TB_S64 + i] = sinf(a); }
        for (int i = lane; i < 2048; i += 64) { const int pos = i >> 5, j = i & 31; const float fr = powf(10000.0f, -(float)j / 32.0f), a = (float)pos * fr; tab[TB_C128 + i] = cosf(a); tab[TB_S128 + i] = sinf(a); }
        for (int l = 0; l < 2; ++l) {
            const float d1 = wave_sum(PIN(I_LQ1)[l * 64 + lane] * PIN(I_LK1)[l * 64 + lane]), d2 = wave_sum(PIN(I_LQ2)[l * 64 + lane] * PIN(I_LK2)[l * 64 + lane]);
            const float lam_init = 0.8f - 0.6f * expf(-0.3f * (float)l);
            if (lane == 0) { tab[TB_LAM + 2 * l] = expf(d1) - expf(d2) + lam_init; tab[TB_LAM + 2 * l + 1] = lam_init; }
        }
    }
    LAS unsigned* scr = (LAS unsigned*)(lds + wave * 16384);
    constexpr int IT_IN = 64 * 205, IT_UQ = 12 * 24, IT_UKV = 8 * 32, IT_PAD = 192, IT_L = IT_IN + IT_UQ + IT_UKV + IT_PAD;
    for (int it = gw; it < 2 * IT_L; it += NGW) {
        const int l = it / IT_L; int r = it - l * IT_L;
        if (r < IT_IN) { const int kb = r / 205, nb = r - kb * 205, nn = nb * 64; const int ns = nn < 5376 ? nn : (nn < 13056 ? nn + 64 : nn - 13056 + 5376);
            transpose_item(PIN(I_WIN) + (size_t)l * DM * INC, INC, kb * 64, ns, (bf16_t*)(ws + WS_BT1 + l * BT1_L), DM, nn, scr, lane); continue; }
        r -= IT_IN;
        if (r < IT_UQ) { const int kb = r / 24, nb = r - kb * 24; transpose_item(PIN(I_WUQ) + (size_t)l * 768 * 1536, 1536, kb * 64, nb * 64, (bf16_t*)(ws + WS_BUQ + l * BUQ_L), 768, nb * 64, scr, lane, PIN(I_BQN) + (size_t)l * 768); continue; }
        r -= IT_UQ;
        if (r < IT_UKV) { const int kb = r >> 5, nb = r & 31; transpose_item(PIN(I_WUKV) + (size_t)l * 512 * 2048, 2048, kb * 64, nb * 64, (bf16_t*)(ws + WS_BUKV + l * BUKV_L), 512, nb * 64, scr, lane, PIN(I_BKVN) + (size_t)l * 512); continue; }
        r -= IT_UKV;
        { u32x4* p = (u32x4*)((bf16_t*)(ws + WS_BT1 + l * BT1_L) + (size_t)(INC + r) * DM) + lane;
#pragma unroll
          for (int j = 0; j < 8; ++j) p[64 * j] = (u32x4){0u, 0u, 0u, 0u}; }
    }
}

__device__ __forceinline__ void ph_wout(LAS unsigned char* lds, int l, int wv, int wg0, int nwg) {
    KARGS_P(); PH_IDS();
    if (wg0 < 0) return;
    PH_WS();
    LAS unsigned* scr = (LAS unsigned*)(lds + wave * 16384);
    for (int r = wg0 * NWAVES + wave; r < 64 * 64; r += nwg * NWAVES) { const int kb = r >> 6, nb = r & 63;
        transpose_item(PIN(I_WOUT) + (size_t)l * DM * DM, DM, kb * 64, nb * 64, (bf16_t*)(ws + WS_BT2 + l * BT2_L), DM, nb * 64, scr, lane); }
}

__device__ __forceinline__ void ph_norm(LAS unsigned char* lds, int l, int wv) {
    KARGS_P(); PH_IDS();
    PH_WS();
    const float* mod = (const float*)(ws + WS_CTL + CTL_MOD) + (size_t)l * 5 * 12288;
    const float* g = PIN(I_NORMG) + (size_t)l * DM;
    bf16_t* H = (bf16_t*)(ws + WS_H);
    const int G = gridDim.x, rpb = (NTOK + G - 1) / G, row0 = blockIdx.x * rpb, row1 = row0 + rpb < NTOK ? row0 + rpb : NTOK;
    if (row0 >= row1) return;
    const int vlo = row0 < NP ? 0 : 1 + ((row0 - NP) >> 11), vhi = (row1 - 1) < NP ? 0 : 1 + ((row1 - 1 - NP) >> 11);
    LAS f32x4* AB = (LAS f32x4*)lds;
    for (int i = wave * 64 + lane; i < 2048; i += NTHR) { const int hiv = i >> 10, c = (i & 1023) * 4; const float* mv = mod + (size_t)(hiv ? vhi : vlo) * 12288;
        const f32x4 gg = *(const f32x4*)(g + c), sh = *(const f32x4*)(mv + c), scl = *(const f32x4*)(mv + 4096 + c);
        AB[(hiv * 2) * 1024 + (i & 1023)] = gg * (scl + 1.0f); AB[(hiv * 2 + 1) * 1024 + (i & 1023)] = sh; }
    __syncthreads();
#define NORM_XR(tok_) ((tok_) < NP ? PIN(I_XP) + (size_t)(tok_) * DM : PIN(I_XS) + (size_t)((tok_) - NP) * DM)
    const bf16_t* DL = (const bf16_t*)(ws + WS_OB);
    for (int tok = row0 + wave; tok < row1; tok += NWAVES) {
        f32x4 x[16]; const float* xr = NORM_XR(tok);
#pragma unroll
        for (int j = 0; j < 16; ++j) x[j] = *(const f32x4*)(xr + (j * 64 + lane) * 4);
        if (l) { u32x2 d[16];
#pragma unroll
            for (int j = 0; j < 16; ++j) d[j] = *(const u32x2*)(DL + (size_t)tok * DM + (j * 64 + lane) * 4);
            __builtin_amdgcn_sched_barrier(0);
#pragma unroll
            for (int j = 0; j < 16; ++j) { x[j][0] += bflo(d[j].x); x[j][1] += bfhi(d[j].x); x[j][2] += bflo(d[j].y); x[j][3] += bfhi(d[j].y); } }
        __builtin_amdgcn_sched_barrier(0);
        const int v = tok < NP ? 0 : 1 + ((tok - NP) >> 11);
        const LAS f32x4* Av = AB + (v == vlo ? 0 : 2048); const LAS f32x4* Bv = Av + 1024;
        float ss = 0.f;
#pragma unroll
        for (int j = 0; j < 16; ++j) ss += (x[j][0] * x[j][0] + x[j][1] * x[j][1]) + (x[j][2] * x[j][2] + x[j][3] * x[j][3]);
        const float rstd = 1.0f / sqrtf(wave_sum(ss) * (1.0f / DM) + EPS);
        bf16_t* hr = H + (size_t)tok * DM;
#pragma unroll
        for (int j = 0; j < 16; ++j) { const int c4 = j * 64 + lane; const f32x4 y = (x[j] * rstd) * Av[c4] + Bv[c4];
            u32x2 w; w.x = pk2(y[0], y[1]); w.y = pk2(y[2], y[3]); *(u32x2*)(hr + c4 * 4) = w; }
    }
#undef NORM_XR
    __syncthreads();
}

__device__ __forceinline__ void ld16(const bf16_t* p, float (&x)[16]) { const u32x4 a = *(const u32x4*)p, b = *(const u32x4*)(p + 8);
    x[0] = bflo(a.x); x[1] = bfhi(a.x); x[2] = bflo(a.y); x[3] = bfhi(a.y); x[4] = bflo(a.z); x[5] = bfhi(a.z); x[6] = bflo(a.w); x[7] = bfhi(a.w);
    x[8] = bflo(b.x); x[9] = bfhi(b.x); x[10] = bflo(b.y); x[11] = bfhi(b.y); x[12] = bflo(b.z); x[13] = bfhi(b.z); x[14] = bflo(b.w); x[15] = bfhi(b.w); }
__device__ __forceinline__ void st16(bf16_t* p, const float (&x)[16]) { u32x4 a, b; a.x = pk2(x[0], x[1]); a.y = pk2(x[2], x[3]); a.z = pk2(x[4], x[5]); a.w = pk2(x[6], x[7]);
    b.x = pk2(x[8], x[9]); b.y = pk2(x[10], x[11]); b.z = pk2(x[12], x[13]); b.w = pk2(x[14], x[15]); *(u32x4*)p = a; *(u32x4*)(p + 8) = b; }
__device__ __forceinline__ void st16f(float* p, const float (&x)[16]) {
#pragma unroll
    for (int j = 0; j < 4; ++j) *(f32x4*)(p + 4 * j) = (f32x4){x[4 * j], x[4 * j + 1], x[4 * j + 2], x[4 * j + 3]}; }
__device__ __forceinline__ void ld4(const bf16_t* p, float (&x)[4]) { const u32x2 a = *(const u32x2*)p; x[0] = bflo(a.x); x[1] = bfhi(a.x); x[2] = bflo(a.y); x[3] = bfhi(a.y); }
__device__ __forceinline__ void st4(bf16_t* p, const float (&x)[4]) { u32x2 a; a.x = pk2(x[0], x[1]); a.y = pk2(x[2], x[3]); *(u32x2*)p = a; }
__device__ __forceinline__ void cvt16(const float* src, bf16_t* dst) { float x[16];
#pragma unroll
    for (int j = 0; j < 4; ++j) { const f32x4 v = *(const f32x4*)(src + 4 * j); x[4 * j] = v[0]; x[4 * j + 1] = v[1]; x[4 * j + 2] = v[2]; x[4 * j + 3] = v[3]; }
    st16(dst, x); }

__device__ __forceinline__ void up8(const u32x4 w, float (&x)[16], int o) { x[o] = bflo(w.x); x[o + 1] = bfhi(w.x); x[o + 2] = bflo(w.y); x[o + 3] = bfhi(w.y); x[o + 4] = bflo(w.z); x[o + 5] = bfhi(w.z); x[o + 6] = bflo(w.w); x[o + 7] = bfhi(w.w); }
__device__ __forceinline__ u32x4 pk8(const float (&x)[16], int o) { u32x4 w; w.x = pk2(x[o], x[o + 1]); w.y = pk2(x[o + 2], x[o + 3]); w.z = pk2(x[o + 4], x[o + 5]); w.w = pk2(x[o + 6], x[o + 7]); return w; }
template <int MODE> __device__ __forceinline__ void ph_post(int l, int wv, int wg0, int nwg) {
    KARGS_P(); PH_IDS();
    if (wg0 < 0) return;
    PH_WS();
    bf16_t* Z = (bf16_t*)(ws + WS_Z);
    const float* tab = (const float*)(ws + WS_TAB);
    float* out = GLOBAL_PTR(float, P.out);
    const float* rsskv = (const float*)(ws + WS_CTL + CTL_RSS) + (size_t)(l * 2 + 1) * NKV;
    constexpr int NIT = MODE == 0 ? NLB * PAST : NTOK;
    for (int it = wg0 * NWAVES + wave; it < NIT; it += nwg * NWAVES) {
        const int r = MODE == 0 ? NP + (it >> 8) * LKV + LSEQ + (it & 255) : kvrow_of_tok(it);
        int lq = lane; asm volatile("" : "+v"(lq));
        bf16_t* zr = Z + (size_t)r * LDZ;
        bool lat = false; int t = 0, pb = 0, lb = 0, cp = -1;
        if (r < NP) { pb = r >> 8; t = r & 255; }
        else { const int rr = r - NP; lb = rr / LKV; const int s_ = rr - lb * LKV; if (s_ < LSEQ) { lat = true; t = s_; } else cp = s_ - LSEQ; }
        if (cp >= 0) {
            const size_t ci = (size_t)(lb * 2 + l) * PAST + cp;
            f32x4 va[4][4];
            const float* s4[4] = {PIN(I_CAK) + ci * 1024 + lq * 16, PIN(I_CAV) + ci * 1024 + lq * 16, PIN(I_CDK) + ci * 1024 + lq * 16, PIN(I_CDV) + ci * 1024 + lq * 16};
#pragma unroll
            for (int q = 0; q < 4; ++q)
#pragma unroll
                for (int j = 0; j < 4; ++j) va[q][j] = *(const f32x4*)(s4[q] + 4 * j);
            const f32x4 ck = *(const f32x4*)(PIN(I_CCK) + ci * 256 + lq * 4), cv = *(const f32x4*)(PIN(I_CCV) + ci * 256 + lq * 4);
            const f32x4 b0 = *(const f32x4*)(PIN(I_CBCKV) + ci * 512 + lq * 8), b1 = *(const f32x4*)(PIN(I_CBCKV) + ci * 512 + lq * 8 + 4);
            const float kp = PIN(I_CBKPE)[ci * 64 + lq];
            const int dcol[4] = {ZC_AK, ZC_AV, ZC_DK, ZC_DV};
#pragma unroll
            for (int q = 0; q < 4; ++q) { u32x4 w0, w1; w0.x = pk2(va[q][0][0], va[q][0][1]); w0.y = pk2(va[q][0][2], va[q][0][3]); w0.z = pk2(va[q][1][0], va[q][1][1]); w0.w = pk2(va[q][1][2], va[q][1][3]);
                w1.x = pk2(va[q][2][0], va[q][2][1]); w1.y = pk2(va[q][2][2], va[q][2][3]); w1.z = pk2(va[q][3][0], va[q][3][1]); w1.w = pk2(va[q][3][2], va[q][3][3]);
                *(u32x4*)(zr + dcol[q] + lq * 16) = w0; *(u32x4*)(zr + dcol[q] + lq * 16 + 8) = w1; }
            { u32x2 w; w.x = pk2(ck[0], ck[1]); w.y = pk2(ck[2], ck[3]); *(u32x2*)(zr + ZC_CK + lq * 4) = w; w.x = pk2(cv[0], cv[1]); w.y = pk2(cv[2], cv[3]); *(u32x2*)(zr + ZC_CV + lq * 4) = w; }
            { const f32x4 g0 = *(const f32x4*)(PIN(I_BKVN) + (size_t)l * 512 + lq * 8), g1 = *(const f32x4*)(PIN(I_BKVN) + (size_t)l * 512 + lq * 8 + 4);
              u32x4 w; w.x = pk2(b0[0] / g0[0], b0[1] / g0[1]); w.y = pk2(b0[2] / g0[2], b0[3] / g0[3]); w.z = pk2(b1[0] / g1[0], b1[1] / g1[1]); w.w = pk2(b1[2] / g1[2], b1[3] / g1[3]); *(u32x4*)(zr + ZC_BCKV + lq * 8) = w; }
            zr[ZC_BKPE + lq] = (bf16_t)f2bf(kp);
            continue;
        }
        const size_t po = (size_t)(pb * 2 + l) * PSEQ + t;
        const int prow = t >> 6, pcol = t & 63;
        const f32x4 gkv0 = *(const f32x4*)(PIN(I_BKVN) + (size_t)l * 512 + lq * 8), gkv1 = *(const f32x4*)(PIN(I_BKVN) + (size_t)l * 512 + lq * 8 + 4);
        const f32x4 gck = *(const f32x4*)(PIN(I_CKN) + l * 128 + (lq & 31) * 4);
        const u32x4 r_ckv = *(const u32x4*)(zr + ZC_BCKV + lq * 8);
        const unsigned short r_kpe = zr[ZC_BKPE + lq];
        const u32x2 r_ck = *(const u32x2*)(zr + ZC_CK + lq * 4);
        const u32x4 r_dk0 = *(const u32x4*)(zr + ZC_DK + lq * 16), r_dk1 = *(const u32x4*)(zr + ZC_DK + lq * 16 + 8);
        float t_kc = 0.f, t_ks = 0.f; f32x4 t_dc[4] = {}, t_ds[4] = {}, t_cc = {}, t_cs = {};
        const int lh32 = lq & 31, lv = lq & 3;
        if (lat) {
            { const int pos = lq < 32 ? prow : pcol, j = lq & 15; t_kc = tab[TB_C64 + pos * 16 + j]; t_ks = tab[TB_S64 + pos * 16 + j]; }
            { const int pos = (lh32 >> 3) < 2 ? prow : pcol, fb = (lh32 & 7) * 4; t_cc = *(const f32x4*)(tab + TB_C128 + pos * 32 + fb); t_cs = *(const f32x4*)(tab + TB_S128 + pos * 32 + fb); }
            { const int pos = lv < 2 ? prow : pcol;
#pragma unroll
              for (int j = 0; j < 4; ++j) { t_dc[j] = *(const f32x4*)(tab + TB_C64 + pos * 16 + 4 * j); t_ds[j] = *(const f32x4*)(tab + TB_S64 + pos * 16 + 4 * j); } }
        }
        asm volatile("" ::: "memory"); __builtin_amdgcn_sched_barrier(0);
        if (!lat) { const float x[8] = {bflo(r_ckv.x), bfhi(r_ckv.x), bflo(r_ckv.y), bfhi(r_ckv.y), bflo(r_ckv.z), bfhi(r_ckv.z), bflo(r_ckv.w), bfhi(r_ckv.w)};
          const float rstd = 1.0f / sqrtf(rsskv[r] * (1.0f / 512.0f) + EPS);
          float* op = out + O_BCKV + po * 512 + lq * 8; *(f32x4*)op = (f32x4){x[0] * rstd * gkv0[0], x[1] * rstd * gkv0[1], x[2] * rstd * gkv0[2], x[3] * rstd * gkv0[3]};
          *(f32x4*)(op + 4) = (f32x4){x[4] * rstd * gkv1[0], x[5] * rstd * gkv1[1], x[6] * rstd * gkv1[2], x[7] * rstd * gkv1[3]}; }
        { const float x = bf2f(r_kpe);
          if (!lat) out[O_BKPE + po * 64 + lq] = x;
          else { const float xp = shx<16>(x); const float y = (lq & 16) ? x * t_kc + xp * t_ks : x * t_kc - xp * t_ks; zr[ZC_BKPE + lq] = (bf16_t)f2bf(y); } }
        { float x[4] = {bflo(r_ck.x), bfhi(r_ck.x), bflo(r_ck.y), bfhi(r_ck.y)}; float ss = (x[0] * x[0] + x[1] * x[1]) + (x[2] * x[2] + x[3] * x[3]);
          ss += shx<1>(ss); ss += shx<2>(ss); ss += shx<4>(ss); ss += shx<8>(ss); ss += shx<16>(ss);
          const float rstd = 1.0f / sqrtf(ss * (1.0f / 128.0f) + EPS);
#pragma unroll
          for (int e = 0; e < 4; ++e) x[e] = x[e] * rstd * gck[e];
          if (!lat) *(f32x4*)(out + O_CK + po * 256 + lq * 4) = (f32x4){x[0], x[1], x[2], x[3]};
          else { const bool second = (lh32 >> 3) & 1;
#pragma unroll
              for (int e = 0; e < 4; ++e) { const float xp = shx<8>(x[e]); x[e] = second ? x[e] * t_cc[e] + xp * t_cs[e] : x[e] * t_cc[e] - xp * t_cs[e]; } }
          u32x2 w; w.x = pk2(x[0], x[1]); w.y = pk2(x[2], x[3]); *(u32x2*)(zr + ZC_CK + lq * 4) = w; }
        if (lat) {
            const bool second = lv & 1;
#pragma unroll
            for (int w = 1; w < 2; ++w) { float x[16]; up8(r_dk0, x, 0); up8(r_dk1, x, 8);
#pragma unroll
                for (int e = 0; e < 16; ++e) { const float xp = shx<1>(x[e]); const float cs = t_dc[e >> 2][e & 3], sn = t_ds[e >> 2][e & 3]; x[e] = second ? x[e] * cs + xp * sn : x[e] * cs - xp * sn; }
                bf16_t* p = zr + (w == 0 ? ZC_DQ : ZC_DK) + lq * 16; *(u32x4*)p = pk8(x, 0); *(u32x4*)(p + 8) = pk8(x, 8); }
        }
    }
}

__device__ __forceinline__ void ph_final(int wv) {
    KARGS_P(); PH_IDS();
    PH_WS();
    const float* g = PIN(I_FNG);
    const bf16_t* D0 = (const bf16_t*)(ws + WS_OB); const bf16_t* D1 = (const bf16_t*)(ws + WS_X);
    const unsigned lo16 = (unsigned)lane * 16u, lo8 = (unsigned)lane * 8u;
#define FX(xr_, j) (*(const f32x4*)((const char*)(xr_) + (j) * 1024 + lo16))
#define FD(D_, tok_, j) (*(const u32x2*)((const char*)((D_) + (size_t)(tok_) * DM) + (j) * 512 + lo8))
    for (int tok = gw; tok < NTOK; tok += NGW) {
        const float* xr = tok < NP ? PIN(I_XP) + (size_t)tok * DM : PIN(I_XS) + (size_t)(tok - NP) * DM;
        f32x4 x[16]; u32x2 d[16], e[16]; float ss = 0.f;
#pragma unroll
        for (int j = 0; j < 16; ++j) { x[j] = FX(xr, j); d[j] = FD(D0, tok, j); e[j] = FD(D1, tok, j); }
        __builtin_amdgcn_sched_barrier(0);
#pragma unroll
        for (int j = 0; j < 16; ++j) { x[j][0] = (x[j][0] + bflo(d[j].x)) + bflo(e[j].x); x[j][1] = (x[j][1] + bfhi(d[j].x)) + bfhi(e[j].x); x[j][2] = (x[j][2] + bflo(d[j].y)) + bflo(e[j].y); x[j][3] = (x[j][3] + bfhi(d[j].y)) + bfhi(e[j].y);
            ss += (x[j][0] * x[j][0] + x[j][1] * x[j][1]) + (x[j][2] * x[j][2] + x[j][3] * x[j][3]); }
        const float rstd = 1.0f / sqrtf(wave_sum(ss) * (1.0f / DM) + EPS);
        char* orow = (char*)(GLOBAL_PTR(float, P.out) + (size_t)tok * DM);
#pragma unroll
        for (int j = 0; j < 16; ++j) { *(f32x4*)(orow + j * 1024 + lo16) = (x[j] * rstd) * *(const f32x4*)((const char*)g + j * 1024 + lo16); if ((j & 3) == 3) asm volatile("" ::: "memory"); }
    }
#undef FX
#undef FD
}

constexpr int N_PHASES = 14;
__global__ void __launch_bounds__(NTHR, 2) fwd_kernel(Params Pk) {
    extern __shared__ __attribute__((aligned(16))) unsigned char lds_raw[];
    LAS unsigned char* lds = (LAS unsigned char*)lds_raw;
    volatile LAS unsigned* MISC = (volatile LAS unsigned*)(lds + MISC_OFF);
    const int wv = __builtin_amdgcn_readfirstlane((int)threadIdx.x >> 6);
    const int G = gridDim.x;
    (void)Pk;
    unsigned* ctl; { KARGS_P(); ctl = GLOBAL_PTR(unsigned, (unsigned*)(P.ws + WS_CTL)); }
#define LEADER() (wv == 0 && lane_id() == 0)
    if (wv == 0 && lane_id() < 32) MISC[lane_id()] = 0u;
    __syncthreads();
    XcdBarrier bar; bar.bar = ctl + CW_BAR; bar.x = 0; bar.st = nullptr;
    if (MK_MODE == 0) bar = xcd_barrier_post(ctl + CW_BAR, MISC + 8, LEADER());
    int lo, hi; { KARGS_P(); lo = P.ph_lo; hi = P.ph_hi; } (void)lo; (void)hi;
#ifndef PH_MASK
#define PH_MASK 0x3fffu
#endif
#if MK_MODE == 0
#define IN(k) ((PH_MASK >> (k)) & 1u)
#else
#define IN(k) (((PH_MASK >> (k)) & 1u) && lo <= (k) && (k) < hi)
#endif
#define STAMP(i) do { if (PROBE_T && blockIdx.x == 0 && LEADER()) { const unsigned long long r_ = PROBE_TC ? (unsigned long long)clock64() / 10ull : (unsigned long long)wall_clock64(); MISC[64 + 2 * (i)] = (unsigned)r_; MISC[65 + 2 * (i)] = (unsigned)(r_ >> 32); } } while (0)
#define SEAM(k) do { if (IN(k) && IN((k) + 1)) xcd_barrier(bar, LEADER()); STAMP((k) + 1); } while (0)
    STAMP(0);
    if (IN(0)) { ph_prologue(lds, true, wv); if (PROBE_DUP & 256) ph_prologue(lds, false, wv); }
    SEAM(0);
    for (int l = 0; l < DEPTH; ++l) {
        const int pb = 1 + 6 * l;
        if (PROBE_SLEEP && l == 1) { const unsigned long long t0_ = wall_clock64(); while (wall_clock64() - t0_ < (unsigned long long)PROBE_SLEEP * 100ull) __builtin_amdgcn_s_sleep(32); }
        if (IN(pb + 0)) { ph_norm(lds, l, wv); if (PROBE_DUP & 512) ph_norm(lds, l, wv); }
        SEAM(pb + 0);
        if (PROBE_CLK && l == PROBE_CLK_L && LEADER()) { const unsigned long long c_ = clock64(), r_ = wall_clock64(); MISC[20] = (unsigned)c_; MISC[21] = (unsigned)(c_ >> 32); MISC[22] = (unsigned)r_; MISC[23] = (unsigned)(r_ >> 32); }
        for (int rep_ = 0; rep_ < ((PROBE_DUP & 2) ? 2 : 1); ++rep_)
        if (IN(pb + 1)) { PH_KWS();
            pg8::Gemm g{(const bf16_t*)(ws + WS_H), (const bf16_t*)(ws + WS_BT1 + l * BT1_L), NTOK, LDZ, DM, DM, DM}; pg8::StaticOrder S; S.init(NTOK, LDZ, G, (int)blockIdx.x);
            pg8::EpiZ E{(bf16_t*)(ws + WS_Z), GLOBAL_PTR(float, P.out), l, (float*)(ws + WS_CTL + CTL_RSS) + (size_t)l * 2 * NKV};
            pg8::gemm_phase<pg8::EpiZ, pg8::StaticOrder>(lds, g, S, E, wv);
            { const int nwg_ = (NTOK / 256) * (LDZ / 256), rem_ = nwg_ % G;
              if (rem_ == 0) { ph_post<0>(l, wv, (int)blockIdx.x, G); ph_wout(lds, l, wv, (int)blockIdx.x, G); } else { ph_post<0>(l, wv, (int)blockIdx.x - rem_, G - rem_); ph_wout(lds, l, wv, (int)blockIdx.x - rem_, G - rem_); } }
        }
        if (PROBE_CLK && l == PROBE_CLK_L && LEADER()) { const unsigned long long c_ = clock64(), r_ = wall_clock64(); MISC[24] = (unsigned)c_; MISC[25] = (unsigned)(c_ >> 32); MISC[26] = (unsigned)r_; MISC[27] = (unsigned)(r_ >> 32);
            const unsigned long long r0_ = ((unsigned long long)MISC[23] << 32) | MISC[22]; const unsigned d_ = (unsigned)(r_ - r0_); atomicMax(ctl + 12000, d_); atomicMax(ctl + 12064, 0x7fffffffu ^ d_); }
        SEAM(pb + 1);
        for (int rep_ = 0; rep_ < ((PROBE_DUP & 8) ? 2 : 1); ++rep_)
        if (IN(pb + 3)) ph_post<1>(l, wv, (int)blockIdx.x, G);
        if (IN(pb + 3)) { PH_KWS();
            { pg8::Gemm g{(const bf16_t*)(ws + WS_Z) + ZC_BCQ, (const bf16_t*)(ws + WS_BUQ + l * BUQ_L), NKV, 1536, 768, LDZ, 768}; pg8::StaticOrder S; S.init(NKV, 1536, G, (int)blockIdx.x);
              pg8::EpiScale E{(bf16_t*)(ws + WS_QB), LDQB, (const float*)(ws + WS_CTL + CTL_RSS) + (size_t)(l * 2) * NKV, 1.0f / 768.0f, 0};
              pg8::gemm_phase<pg8::EpiScale, pg8::StaticOrder>(lds, g, S, E, wv); }
            { pg8::Gemm g{(const bf16_t*)(ws + WS_Z) + ZC_BCKV, (const bf16_t*)(ws + WS_BUKV + l * BUKV_L), NKV, 2048, 512, LDZ, 512}; pg8::StaticOrder S; S.init(NKV, 2048, G, G - 1 - (int)blockIdx.x);
              pg8::EpiScale E{(bf16_t*)(ws + WS_KVB), LDKVB, (const float*)(ws + WS_CTL + CTL_RSS) + (size_t)(l * 2 + 1) * NKV, 1.0f / 512.0f, 1};
              pg8::gemm_phase<pg8::EpiScale, pg8::StaticOrder>(lds, g, S, E, wv); }
        }
        SEAM(pb + 3);
        if (IN(pb + 4)) { PH_KWS();
            for (int rnd = 0; rnd < ((PROBE_DUP & 32) ? 4 : 2); ++rnd) {
#define ATT_SECT(sect, DQV, KWV, MSK, DPR) do { const int nu_ = attn_nunits(sect, rnd & 1); \
                if (nu_ > 0) { const att::SectCtx C_{sect, rnd & 1, l, nu_, ctl + CW_Q + 64 * ((l * 4 + rnd) * 4 + sect), (bf16_t*)(ws + WS_Z), (bf16_t*)(ws + WS_QB), (bf16_t*)(ws + WS_KVB), (bf16_t*)(ws + WS_Y), PIN(I_RPB), (const float*)(ws + WS_TAB), PIN(I_SUBLN), PIN(I_CQN)}; \
                    att::attn_section<DQV, KWV, MSK, DPR>(C_, (char*)lds_raw, wv); } } while (0)
#ifndef SECT_MASK
#define SECT_MASK 15
#endif
                if (SECT_MASK & 1) ATT_SECT(0, 192, 192, false, false);
                if (SECT_MASK & 2) ATT_SECT(1, 128, 128, false, false);
                if (SECT_MASK & 4) ATT_SECT(2, 64, 128, false, true);
                if ((SECT_MASK & 8) && (rnd & 1) == 0) ATT_SECT(3, 128, 128, true, false);
#undef ATT_SECT
            }
        }
        SEAM(pb + 4);
        for (int rep_ = 0; rep_ < (((PROBE_DUP & 64) && l == 0) ? 3 : 1); ++rep_)
        if (IN(pb + 5)) { PH_KWS();
            pg8::Gemm g{(const bf16_t*)(ws + WS_Y), (const bf16_t*)(ws + WS_BT2 + l * BT2_L), NTOK, DM, DM, DM, DM}; pg8::StaticOrder S; S.init(NTOK, DM, G, (int)blockIdx.x);
            pg8::EpiDelta E{(bf16_t*)(ws + (l == 0 ? WS_OB : WS_X)), (const float*)(ws + WS_CTL + CTL_MOD) + (size_t)l * 5 * 12288 + 8192};
            pg8::gemm_phase<pg8::EpiDelta, pg8::StaticOrder>(lds, g, S, E, wv);
        }
        SEAM(pb + 5);
    }
    if (IN(13)) { ph_final(wv); if (PROBE_DUP & 2048) ph_final(wv); }
    STAMP(14);
    if (PROBE_T && blockIdx.x == 0 && LEADER()) {
        const unsigned long long ta = ((unsigned long long)MISC[65 + 2 * PROBE_T] << 32) | MISC[64 + 2 * PROBE_T], tb = ((unsigned long long)MISC[65 + 2 * PROBE_T2] << 32) | MISC[64 + 2 * PROBE_T2];
        const unsigned long long spin = (ta - tb) * PROBE_MUL, t0 = wall_clock64(); while (wall_clock64() - t0 < spin) __builtin_amdgcn_s_sleep(8);
    }
    if (PROBE_CLK && blockIdx.x == 0 && LEADER()) {
        const unsigned long long c0 = ((unsigned long long)MISC[21] << 32) | MISC[20], r0 = ((unsigned long long)MISC[23] << 32) | MISC[22], c1 = ((unsigned long long)MISC[25] << 32) | MISC[24], r1 = ((unsigned long long)MISC[27] << 32) | MISC[26];
        const unsigned long long dr = r1 - r0, dc = c1 - c0;
        const unsigned long long spin = PROBE_CLK == 1 ? (dr ? dc * 100ull * 100ull / dr : 0ull) : PROBE_CLK == 2 ? dr : PROBE_CLK == 3 ? (unsigned long long)__hip_atomic_load(ctl + 12000, __ATOMIC_RELAXED, __HIP_MEMORY_SCOPE_AGENT) : (unsigned long long)(0x7fffffffu ^ __hip_atomic_load(ctl + 12064, __ATOMIC_RELAXED, __HIP_MEMORY_SCOPE_AGENT));
        const unsigned long long t0 = wall_clock64(); while (wall_clock64() - t0 < spin) __builtin_amdgcn_s_sleep(8);
    }
#undef IN
#undef SEAM
}

extern "C" void kernel_launch(void* const* d_in, const int* in_sizes, int n_in, void* d_out, int out_size, void* d_ws, size_t ws_size, hipStream_t stream) {
    static int grid = 0;
    if (grid == 0) {
        if (n_in != 30 || (size_t)out_size != O_END || ws_size < WS_END) { fprintf(stderr, "kernel_launch: shape mismatch: n_in %d out %d ws %zu (need %zu)\n", n_in, out_size, ws_size, (size_t)WS_END); grid = -1; return; }
        int dev = 0, cus = 0, per_cu = 0;
        if (hipGetDevice(&dev) != hipSuccess || hipDeviceGetAttribute(&cus, hipDeviceAttributeMultiprocessorCount, dev) != hipSuccess) { fprintf(stderr, "kernel_launch: device query failed\n"); grid = -1; return; }
        if (hipFuncSetAttribute((const void*)fwd_kernel, hipFuncAttributeMaxDynamicSharedMemorySize, LDS_BYTES) != hipSuccess) { fprintf(stderr, "kernel_launch: hipFuncSetAttribute failed\n"); grid = -1; return; }
        if (hipOccupancyMaxActiveBlocksPerMultiprocessor(&per_cu, (const void*)fwd_kernel, NTHR, LDS_BYTES) != hipSuccess || per_cu < 1)
            fprintf(stderr, "kernel_launch: note: occupancy query reports %d workgroups per CU\n", per_cu);
        (void)hipGetLastError();
        grid = cus;
    }
    if (grid < 0) return;
    if (hipMemsetAsync((char*)d_ws + WS_CTL, 0, CTL_BYTES, stream) != hipSuccess) { fprintf(stderr, "kernel_launch: memset failed\n"); return; }
    Params p{};
    for (int i = 0; i < 30; ++i) p.in[i] = (const float*)d_in[i];
    p.out = (float*)d_out; p.ws = (unsigned char*)d_ws;
#if MK_MODE == 0
    p.ph_lo = 0; p.ph_hi = N_PHASES;
    hipLaunchKernelGGL(fwd_kernel, dim3(grid), dim3(NTHR), LDS_BYTES, stream, p);
#else
    for (int ph = 0; ph < N_PHASES; ++ph) {
        p.ph_lo = ph; p.ph_hi = ph + 1;
        hipLaunchKernelGGL(fwd_kernel, dim3(grid), dim3(NTHR), LDS_BYTES, stream, p);
    }
#endif
    const hipError_t le = hipPeekAtLastError();
    if (le != hipSuccess) fprintf(stderr, "kernel_launch: launch failed: %s\n", hipGetErrorName(le));
}
```

```cpp
#include <hip/hip_runtime.h>
#include <cstdio>
#include <cstdint>

#ifndef MK_MODE
#define MK_MODE 0
#endif
#ifndef PROBE_DUP
#define PROBE_DUP 0
#endif
#ifndef PROBE_T
#define PROBE_T 0
#endif
#ifndef PROBE_T2
#define PROBE_T2 0
#endif
#ifndef PROBE_TC
#define PROBE_TC 0
#endif
#ifndef PROBE_MUL
#define PROBE_MUL 1
#endif
#ifndef PROBE_SLEEP
#define PROBE_SLEEP 0
#endif
#ifndef PROBE_CLK_L
#define PROBE_CLK_L 0
#endif
#ifndef PROBE_CLK
#define PROBE_CLK 0
#endif

#define LAS __attribute__((address_space(3)))
#define GLOBAL_PTR(T, p) ((T*)(__attribute__((address_space(1))) T*)(unsigned long long)(p))
typedef unsigned short bf16_t;
typedef short bf16x8 __attribute__((ext_vector_type(8)));
typedef short s16x4 __attribute__((ext_vector_type(4)));
typedef float f32x4 __attribute__((ext_vector_type(4)));
typedef float f32x2 __attribute__((ext_vector_type(2)));
typedef float f32x16 __attribute__((ext_vector_type(16)));
typedef unsigned u32x4 __attribute__((ext_vector_type(4)));
typedef unsigned u32x2 __attribute__((ext_vector_type(2)));

constexpr int DM = 4096, NPB = 16, PSEQ = 256, NLB = 4, LSEQ = 2048, PAST = 256, DEPTH = 2;
constexpr int NP = NPB * PSEQ, NL = NLB * LSEQ, NTOK = NP + NL;
constexpr int LKV = LSEQ + PAST, NKV = NP + NLB * LKV;
constexpr int INC = 13120, LDZ = 13312;
constexpr float EPS = 1e-6f;
constexpr int ZC_AQ = 0, ZC_AK = 1024, ZC_AV = 2048, ZC_AZ = 3072, ZC_BCQ = 4096, ZC_BCKV = 4864, ZC_BZ = 5376, ZC_CQ = 6400, ZC_CK = 7424, ZC_CV = 7680,
              ZC_CZ = 7936, ZC_DQ = 8960, ZC_DK = 9984, ZC_DV = 11008, ZC_DZ = 12032, ZC_BKPE = 13056;
constexpr int LDQB = 1536, LDKVB = 2048, LDO = 5120;
constexpr size_t O_YP = 0, O_YS = 16777216, O_AK = 50331648, O_AV = 58720256, O_BCKV = 67108864, O_BKPE = 71303168, O_CK = 71827456, O_CV = 73924608,
                 O_DK = 76021760, O_DV = 84410368, O_END = 92798976;
constexpr size_t MiB = 1u << 20;
constexpr size_t WS_CTL = 0, CTL_BYTES = 1 * MiB;
constexpr int CW_BAR = 4096;
constexpr int CW_Q = 8192;
constexpr size_t CTL_RSS = 600064;
constexpr size_t CTL_MOD = 65536;
constexpr size_t WS_TAB = 1 * MiB;
constexpr size_t WS_BT1 = 2 * MiB, BT1_L = (size_t)LDZ * DM * 2;
constexpr size_t WS_BT2 = WS_BT1 + 2 * BT1_L, BT2_L = (size_t)DM * DM * 2;
constexpr size_t WS_BUQ = WS_BT2 + 2 * BT2_L, BUQ_L = (size_t)1536 * 768 * 2;
constexpr size_t WS_BUKV = WS_BUQ + 2 * BUQ_L, BUKV_L = (size_t)2048 * 512 * 2;
constexpr size_t WS_H = WS_BUKV + 2 * BUKV_L;
constexpr size_t WS_Z = WS_H + (size_t)NTOK * DM * 2;
constexpr size_t WS_QB = WS_Z + (size_t)NKV * LDZ * 2;
constexpr size_t WS_KVB = WS_QB + (size_t)NKV * LDQB * 2;
constexpr size_t WS_OB = WS_KVB + (size_t)NKV * LDKVB * 2;
constexpr size_t WS_Y = WS_OB + (size_t)NTOK * LDO * 2;
constexpr size_t WS_X = WS_Y + (size_t)NTOK * DM * 2;
constexpr size_t WS_END = WS_X + (size_t)NTOK * DM * 4;
static_assert(WS_BT1 % 256 == 0 && WS_BT2 % 256 == 0 && WS_BUQ % 256 == 0 && WS_BUKV % 256 == 0 && WS_H % 256 == 0 && WS_Z % 256 == 0 && WS_QB % 256 == 0 && WS_KVB % 256 == 0 &&
              WS_OB % 256 == 0 && WS_Y % 256 == 0 && WS_X % 256 == 0, "ws alignment");
constexpr int TB_C64 = 0, TB_S64 = 1024, TB_C128 = 2048, TB_S128 = 4096, TB_LAM = 6144;
constexpr int RING_BYTES = 131072, ATT_WSF_OFF = 131072, ATT_RPB_OFF = 133120, MISC_OFF = 143360, LDS_BYTES = 147456;
constexpr int NWAVES = 8, NTHR = 512;

#define LDS_WAIT() asm volatile("s_waitcnt lgkmcnt(0)" ::: "memory")
#define VM_WAIT() asm volatile("s_waitcnt vmcnt(0)" ::: "memory")
__device__ __forceinline__ unsigned f2bf(float f) { unsigned u = __builtin_bit_cast(unsigned, f); return (u + 0x7fffu + ((u >> 16) & 1u)) >> 16; }
__device__ __forceinline__ unsigned pk2(float lo, float hi) { return f2bf(lo) | (f2bf(hi) << 16); }
__device__ __forceinline__ float bf2f(unsigned short b) { return __builtin_bit_cast(float, ((unsigned)b) << 16); }
__device__ __forceinline__ float bflo(unsigned w) { return __builtin_bit_cast(float, w << 16); }
__device__ __forceinline__ float bfhi(unsigned w) { return __builtin_bit_cast(float, w & 0xffff0000u); }
__device__ __forceinline__ unsigned cvt_pk_bf16(float lo, float hi) { unsigned r; asm volatile("v_cvt_pk_bf16_f32 %0, %1, %2" : "=v"(r) : "v"(lo), "v"(hi)); return r; }
template <int M> __device__ __forceinline__ float shx(float x) {
    if constexpr (M < 32) return __builtin_bit_cast(float, __builtin_amdgcn_ds_swizzle(__builtin_bit_cast(int, x), (M << 10) | 0x1f));
    else { auto rr = __builtin_amdgcn_permlane32_swap(__builtin_bit_cast(unsigned, x), __builtin_bit_cast(unsigned, x), false, false);
           return __builtin_bit_cast(float, (unsigned)rr[0]) == x ? __builtin_bit_cast(float, (unsigned)rr[1]) : __builtin_bit_cast(float, (unsigned)rr[0]); }
}
__device__ __forceinline__ float wave_sum(float v) {
    v += shx<1>(v); v += shx<2>(v); v += shx<4>(v); v += shx<8>(v); v += shx<16>(v);
    auto rr = __builtin_amdgcn_permlane32_swap(__builtin_bit_cast(unsigned, v), __builtin_bit_cast(unsigned, v), false, false);
    return __builtin_bit_cast(float, (unsigned)rr[0]) + __builtin_bit_cast(float, (unsigned)rr[1]);
}
__device__ __forceinline__ float wave_max(float v) {
    v = fmaxf(v, shx<1>(v)); v = fmaxf(v, shx<2>(v)); v = fmaxf(v, shx<4>(v)); v = fmaxf(v, shx<8>(v)); v = fmaxf(v, shx<16>(v));
    auto rr = __builtin_amdgcn_permlane32_swap(__builtin_bit_cast(unsigned, v), __builtin_bit_cast(unsigned, v), false, false);
    return fmaxf(__builtin_bit_cast(float, (unsigned)rr[0]), __builtin_bit_cast(float, (unsigned)rr[1]));
}
__device__ __forceinline__ int lane_id() { int l; asm volatile("v_mbcnt_lo_u32_b32 %0, -1, 0\n\tv_mbcnt_hi_u32_b32 %0, -1, %0" : "=v"(l)); return l; }
__device__ __forceinline__ float silu_f(float x) { return x / (1.0f + __expf(-x)); }
__device__ __forceinline__ int kvrow_of_tok(int tok) { if (tok < NP) return tok; const int r = tok - NP; return NP + (r >> 11) * LKV + (r & 2047); }

namespace pg8 {
constexpr int BM = 256, BK = 64, HALF = 128, HTB = HALF * BK * 2, STAGE_BYTES = 8 * HTB, NXCD = 8, WGM = 8;
__host__ __device__ __forceinline__ int lds_byte(int r, int c) { const int st = (r >> 4) * 2 + (c >> 5), rr = r & 15, cc = c & 31, ob = rr * 64 + cc * 2; return st * 1024 + (ob ^ (((ob >> 9) & 1) << 5)); }
__host__ __device__ __forceinline__ void stage_rc(int b, int& R, int& C) { const int st = b / 1024, sb = b % 1024, swz = sb ^ (((sb >> 9) & 1) << 5); R = (st >> 1) * 16 + swz / 64; C = (st & 1) * 32 + (swz % 64) / 2; }
__host__ __device__ __forceinline__ int perm32(int rho) { const int n = rho >> 4, i = rho & 15; return 8 * (i >> 2) + 4 * n + (i & 3); }

struct Unit { int pm, pn; };
struct Gemm { const bf16_t* A; const bf16_t* Bt; int M, N, K, lda, ldb; };

struct StaticOrder {
    int nM, nN, nwg, G, c;
    __host__ __device__ void init(int M, int N, int G_, int c_) { nM = M / BM; nN = N / BM; nwg = nM * nN; G = G_; c = c_; }
    __host__ __device__ bool next(int i, Unit& u) const {
        const long L = (long)i * G + c; if (L >= nwg) return false;
        int wgid = (int)L; { const int q = nwg / NXCD, r = nwg % NXCD, xcd = wgid % NXCD, off = wgid / NXCD; wgid = (xcd < r ? xcd * (q + 1) : r * (q + 1) + (xcd - r) * q) + off; }
        const int nig = WGM * nN, gid = wgid / nig, fm = gid * WGM, gsz = (nM - fm) < WGM ? (nM - fm) : WGM;
        u.pm = fm + ((wgid % nig) % gsz); u.pn = (wgid % nig) / gsz; return true;
    }
    __device__ __forceinline__ void a_ready(const Unit&) const {}
    __device__ __forceinline__ void done(const Unit&) const {}
};

struct EpiBf16 {
    static constexpr bool PERM = true;
    bf16_t* O; int ldc; int remap;
    __device__ __forceinline__ void operator()(const f32x4 (&acc)[2][2][4][2], const Unit& u, int wr, int wc, int fr, int fq) const {
        int pmo = u.pm; if (remap && pmo >= 16) { const int j = pmo - 16; pmo = 16 + (j >> 3) * 9 + (j & 7); }
        const int row0 = pmo * BM + wr * 64 + fr, col0 = u.pn * BM + wc * 32 + 8 * fq;
#pragma unroll
        for (int ai = 0; ai < 2; ++ai)
#pragma unroll
            for (int m = 0; m < 4; ++m) { bf16_t* rowp = O + (size_t)(row0 + ai * HALF + m * 16) * ldc + col0;
#pragma unroll
                for (int bj = 0; bj < 2; ++bj) { const f32x4 v0 = acc[ai][bj][m][0], v1 = acc[ai][bj][m][1];
                    u32x4 w; w.x = cvt_pk_bf16(v0[0], v0[1]); w.y = cvt_pk_bf16(v0[2], v0[3]); w.z = cvt_pk_bf16(v1[0], v1[1]); w.w = cvt_pk_bf16(v1[2], v1[3]);
                    if (remap) __builtin_nontemporal_store(w, (u32x4*)(rowp + bj * HALF)); else *(u32x4*)(rowp + bj * HALF) = w; } }
    }
};
struct EpiZ {
    static constexpr bool PERM = true;
    bf16_t* O; float* out; int l; float* rss;
    __device__ __forceinline__ void operator()(const f32x4 (&acc)[2][2][4][2], const Unit& u, int wr, int wc, int fr, int fq) const {
        int pmo = u.pm; if (pmo >= 16) { const int j = pmo - 16; pmo = 16 + (j >> 3) * 9 + (j & 7); }
        const int row0 = pmo * BM + wr * 64 + fr, col0 = u.pn * BM + wc * 32 + 8 * fq;
        if (u.pn >= 16 && u.pn < 21) { float* rp = rss + (u.pn < 19 ? 0 : NKV) + row0;
#pragma unroll
            for (int ai = 0; ai < 2; ++ai)
#pragma unroll
                for (int m = 0; m < 4; ++m) { float q = 0.f;
#pragma unroll
                    for (int bj = 0; bj < 2; ++bj)
#pragma unroll
                        for (int n = 0; n < 2; ++n) { const f32x4 x = acc[ai][bj][m][n]; q += (x[0] * x[0] + x[1] * x[1]) + (x[2] * x[2] + x[3] * x[3]); }
                    q += shx<16>(q); { auto rr = __builtin_amdgcn_permlane32_swap(__float_as_uint(q), __float_as_uint(q), false, false); q = __uint_as_float(rr[0]) + __uint_as_float(rr[1]); }
                    if (fq == 0) atomicAdd(rp + ai * HALF + m * 16, q); } }
#pragma unroll
        for (int ai = 0; ai < 2; ++ai)
#pragma unroll
            for (int m = 0; m < 4; ++m) { bf16_t* rowp = O + (size_t)(row0 + ai * HALF + m * 16) * LDZ + col0;
#pragma unroll
                for (int bj = 0; bj < 2; ++bj) { const f32x4 v0 = acc[ai][bj][m][0], v1 = acc[ai][bj][m][1];
                    u32x4 w; w.x = cvt_pk_bf16(v0[0], v0[1]); w.y = cvt_pk_bf16(v0[2], v0[3]); w.z = cvt_pk_bf16(v1[0], v1[1]); w.w = cvt_pk_bf16(v1[2], v1[3]);
                    __builtin_nontemporal_store(w, (u32x4*)(rowp + bj * HALF)); } }
        if (u.pm < 16) {
            const int pn = u.pn; size_t obase; int W, cb;
            if (pn >= 4 && pn < 8) { obase = O_AK; W = 1024; cb = (pn - 4) * 256; }
            else if (pn >= 8 && pn < 12) { obase = O_AV; W = 1024; cb = (pn - 8) * 256; }
            else if (pn == 30) { obase = O_CV; W = 256; cb = 0; }
            else if (pn >= 39 && pn < 43) { obase = O_DK; W = 1024; cb = (pn - 39) * 256; }
            else if (pn >= 43 && pn < 47) { obase = O_DV; W = 1024; cb = (pn - 43) * 256; }
            else return;
            float* ob = out + obase + ((size_t)(u.pm * 2 + l) * PSEQ + wr * 64 + fr) * W + cb + wc * 32 + 8 * fq;
#pragma unroll
            for (int ai = 0; ai < 2; ++ai)
#pragma unroll
                for (int m = 0; m < 4; ++m) { float* rp = ob + (size_t)(ai * HALF + m * 16) * W;
#pragma unroll
                    for (int bj = 0; bj < 2; ++bj) { __builtin_nontemporal_store(acc[ai][bj][m][0], (f32x4*)(rp + bj * HALF)); __builtin_nontemporal_store(acc[ai][bj][m][1], (f32x4*)(rp + bj * HALF + 4)); } }
        }
    }
};
struct EpiScale {
    static constexpr bool PERM = true;
    bf16_t* O; int ldc; const float* rss; float invK; int cache1;
    __device__ __forceinline__ void operator()(const f32x4 (&acc)[2][2][4][2], const Unit& u, int wr, int wc, int fr, int fq) const {
        const int row0 = u.pm * BM + wr * 64 + fr, col0 = u.pn * BM + wc * 32 + 8 * fq;
        const bool ct = cache1 && u.pm >= 16 && ((u.pm - 16) % 9 == 8);
#pragma unroll
        for (int ai = 0; ai < 2; ++ai)
#pragma unroll
            for (int m = 0; m < 4; ++m) { const int r = row0 + ai * HALF + m * 16; const float rs = ct ? 1.0f : 1.0f / sqrtf(rss[r] * invK + EPS);
                bf16_t* rowp = O + (size_t)r * ldc + col0;
#pragma unroll
                for (int bj = 0; bj < 2; ++bj) { const f32x4 v0 = acc[ai][bj][m][0] * rs, v1 = acc[ai][bj][m][1] * rs;
                    u32x4 w; w.x = cvt_pk_bf16(v0[0], v0[1]); w.y = cvt_pk_bf16(v0[2], v0[3]); w.z = cvt_pk_bf16(v1[0], v1[1]); w.w = cvt_pk_bf16(v1[2], v1[3]);
                    *(u32x4*)(rowp + bj * HALF) = w; } }
    }
};
struct EpiDelta {
    static constexpr bool PERM = true;
    bf16_t* D; const float* gate;
    const float* xp; const float* xs; const bf16_t* xb;
    __device__ __forceinline__ void operator()(const f32x4 (&acc)[2][2][4][2], const Unit& u, int wr, int wc, int fr, int fq) const {
        int rl0_ = wr * 64 + fr; asm volatile("" : "+v"(rl0_));
        const int rl0 = rl0_, row0 = u.pm * BM + rl0, col0 = u.pn * BM + wc * 32 + 8 * fq;
        const int v = u.pm < 16 ? 0 : 1 + ((u.pm - 16) >> 3);
        const float* gv = gate + (size_t)v * 12288 + col0;
        f32x4 g4[2][2];
#pragma unroll
        for (int bj = 0; bj < 2; ++bj)
#pragma unroll
            for (int n = 0; n < 2; ++n) g4[bj][n] = *(const f32x4*)(gv + bj * HALF + 4 * n);
        if (xb) {
#pragma unroll
            for (int ai = 0; ai < 2; ++ai)
#pragma unroll
                for (int m = 0; m < 4; ++m) { const size_t ro = (size_t)(row0 + ai * HALF + m * 16) * DM + col0;
#pragma unroll
                    for (int bj = 0; bj < 2; ++bj) { const u32x4 r = *(const u32x4*)(xb + ro + bj * HALF);
                        const f32x4 v0 = acc[ai][bj][m][0] * g4[bj][0] + (f32x4){bflo(r.x), bfhi(r.x), bflo(r.y), bfhi(r.y)}, v1 = acc[ai][bj][m][1] * g4[bj][1] + (f32x4){bflo(r.z), bfhi(r.z), bflo(r.w), bfhi(r.w)};
                        u32x4 w; w.x = cvt_pk_bf16(v0[0], v0[1]); w.y = cvt_pk_bf16(v0[2], v0[3]); w.z = cvt_pk_bf16(v1[0], v1[1]); w.w = cvt_pk_bf16(v1[2], v1[3]);
                        *(u32x4*)(D + ro + bj * HALF) = w; } }
        } else {
            const float* xu = (u.pm < 16 ? xp + (size_t)(u.pm * BM) * DM : xs + (size_t)(u.pm * BM - NP) * DM) + col0;
#pragma unroll
            for (int ai = 0; ai < 2; ++ai)
#pragma unroll
                for (int m = 0; m < 4; ++m) { const int rl = rl0 + ai * HALF + m * 16; bf16_t* rowp = D + (size_t)(u.pm * BM + rl) * DM + col0; const float* xr = xu + (size_t)rl * DM;
#pragma unroll
                    for (int bj = 0; bj < 2; ++bj) { const f32x4 r0 = *(const f32x4*)(xr + bj * HALF), r1 = *(const f32x4*)(xr + bj * HALF + 4);
                        const f32x4 v0 = acc[ai][bj][m][0] * g4[bj][0] + r0, v1 = acc[ai][bj][m][1] * g4[bj][1] + r1;
                        u32x4 w; w.x = cvt_pk_bf16(v0[0], v0[1]); w.y = cvt_pk_bf16(v0[2], v0[3]); w.z = cvt_pk_bf16(v1[0], v1[1]); w.w = cvt_pk_bf16(v1[2], v1[3]);
                        *(u32x4*)(rowp + bj * HALF) = w; } }
        }
    }
};

#ifndef PG8_SP2
#define PG8_SP2 true
#endif
#ifndef PG8_ALIGN
#define PG8_ALIGN true
#endif
template <class Epi, class Sched, bool ALIGN_EPI = PG8_ALIGN, bool SP2 = PG8_SP2>
__device__ __forceinline__ void gemm_phase(LAS unsigned char* lds, const Gemm g, const Sched& S, const Epi& E, int wv) {
    int lane_ = lane_id(); asm volatile("" : "+v"(lane_));
    const int wid = wv, lane = lane_, tid = wid * 64 + lane, wr = wid >> 2, wc = wid & 3, fr = lane & 15, fq = lane >> 4;
    const int K = g.K, nt = K / BK;
    unsigned voffA[2], voffB[2];
#pragma unroll
    for (int i = 0; i < 2; ++i) { int R, C; stage_rc(tid * 16 + i * 8192, R, C); const int Rb = Epi::PERM ? ((R & ~31) + perm32(R & 31)) : R;
        voffA[i] = (unsigned)(R * g.lda + C) * 2u; voffB[i] = (unsigned)(Rb * g.ldb + C) * 2u; }
    const size_t kstep = (size_t)(BK * 2);
    const size_t hstepA = (size_t)HALF * g.lda * 2, hstepB = (size_t)HALF * g.ldb * 2;
    const size_t tstepA = 2 * hstepA, tstepB = 2 * hstepB;
    const unsigned ldsw = (unsigned)wid * 1024u;
    const int aoff = lds_byte(wr * 64 + fr, fq * 8), boff = lds_byte(wc * 32 + fr, fq * 8);
#define PG8_SA(b, h) (((b) * 2 + (h)) * HTB)
#define PG8_SB(b, h) ((4 + (b) * 2 + (h)) * HTB)
#define PG8_STAGE(bufoff, gbase, voff) do { _Pragma("unroll") for (int _i = 0; _i < 2; ++_i) \
        __builtin_amdgcn_global_load_lds((const unsigned*)((const char*)(gbase) + (voff)[_i]), (LAS unsigned*)(lds + (bufoff) + ldsw + _i * 8192), 16, 0, 0); } while (0)
#define PG8_LDA(dst, b, h) do { _Pragma("unroll") for (int m = 0; m < 4; ++m) _Pragma("unroll") for (int k = 0; k < 2; ++k) dst[m][k] = *(const LAS bf16x8*)(lds + PG8_SA(b, h) + aoff + m * 2048 + k * 1024); } while (0)
#define PG8_LDB(dst, b, h) do { _Pragma("unroll") for (int n = 0; n < 2; ++n) _Pragma("unroll") for (int k = 0; k < 2; ++k) dst[n][k] = *(const LAS bf16x8*)(lds + PG8_SB(b, h) + boff + n * 2048 + k * 1024); } while (0)
#define PG8_MMA(ai, bj, At, Bt) do { __builtin_amdgcn_s_setprio(1); _Pragma("unroll") for (int m = 0; m < 4; ++m) _Pragma("unroll") for (int n = 0; n < 2; ++n) _Pragma("unroll") for (int k = 0; k < 2; ++k) \
        acc[ai][bj][m][n] = __builtin_amdgcn_mfma_f32_16x16x32_bf16(Bt[n][k], At[m][k], acc[ai][bj][m][n], 0, 0, 0); __builtin_amdgcn_s_setprio(0); } while (0)
#define PG8_WAIT_V(n) asm volatile("s_waitcnt vmcnt(" #n ")" ::: "memory")
#define PG8_WAIT_L(n) asm volatile("s_waitcnt lgkmcnt(" #n ")" ::: "memory")
#define PG8_BAR __builtin_amdgcn_s_barrier()
#define PG8_SCHED __builtin_amdgcn_sched_barrier(0)
    Unit cur, nxt; int ui = 0;
    if (!S.next(0, cur)) return;
    f32x4 acc[2][2][4][2];
#pragma unroll
    for (int a = 0; a < 2; ++a)
#pragma unroll
        for (int b = 0; b < 2; ++b)
#pragma unroll
            for (int m = 0; m < 4; ++m)
#pragma unroll
                for (int n = 0; n < 2; ++n) acc[a][b][m][n] = (f32x4){0.f, 0.f, 0.f, 0.f};
    bf16x8 At[4][2], B0[2][2], B1[2][2];
    const char* cA = (const char*)g.A + (size_t)cur.pm * tstepA; const char* cB = (const char*)g.Bt + (size_t)cur.pn * tstepB;
    S.a_ready(cur);
    if constexpr (SP2) {
        PG8_STAGE(PG8_SB(0, 0), cB, voffB); PG8_STAGE(PG8_SB(0, 1), cB + hstepB, voffB); PG8_STAGE(PG8_SA(0, 0), cA, voffA); PG8_STAGE(PG8_SA(0, 1), cA + hstepA, voffA);
        if (wr == 1) PG8_BAR;
        PG8_WAIT_V(2); PG8_BAR;
        PG8_STAGE(PG8_SB(1, 0), cB + kstep, voffB); PG8_STAGE(PG8_SA(1, 0), cA + kstep, voffA); PG8_STAGE(PG8_SB(1, 1), cB + hstepB + kstep, voffB);
        PG8_WAIT_V(6); PG8_BAR;
    } else {
    PG8_STAGE(PG8_SB(0, 0), cB, voffB); PG8_STAGE(PG8_SA(0, 0), cA, voffA); PG8_STAGE(PG8_SB(0, 1), cB + hstepB, voffB); PG8_STAGE(PG8_SA(0, 1), cA + hstepA, voffA);
    if (wr == 1) PG8_BAR;
    PG8_WAIT_V(4); PG8_BAR;
    PG8_STAGE(PG8_SB(1, 0), cB + kstep, voffB); PG8_STAGE(PG8_SA(1, 0), cA + kstep, voffA); PG8_STAGE(PG8_SB(1, 1), cB + hstepB + kstep, voffB);
    PG8_WAIT_V(6); PG8_BAR;
    }
    for (;;) {
        const bool has_next = S.next(ui + 1, nxt);
        const char* nA = has_next ? (const char*)g.A + (size_t)nxt.pm * tstepA : cA; const char* nB = has_next ? (const char*)g.Bt + (size_t)nxt.pn * tstepB : cB;
        for (int t = 0; t < nt; t += 2) {
            const bool last = (t == nt - 2);
            const char* a1 = cA + (size_t)(t + 1) * kstep;
            const char* a2 = last ? nA : cA + (size_t)(t + 2) * kstep; const char* b2 = last ? nB : cB + (size_t)(t + 2) * kstep;
            const char* a3 = a2 + kstep; const char* b3 = b2 + kstep;
            if (last && has_next) S.a_ready(nxt);
            if constexpr (SP2) {
            PG8_LDB(B0, 0, 0); PG8_LDB(B1, 0, 1); PG8_SCHED; PG8_LDA(At, 0, 0); PG8_STAGE(PG8_SA(1, 1), a1 + hstepA, voffA);
            PG8_WAIT_V(8); PG8_WAIT_L(0); PG8_BAR; PG8_MMA(0, 0, At, B0); PG8_MMA(0, 1, At, B1); PG8_BAR; PG8_SCHED;
            PG8_LDA(At, 0, 1); PG8_STAGE(PG8_SB(0, 0), b2, voffB); PG8_STAGE(PG8_SB(0, 1), b2 + hstepB, voffB); PG8_STAGE(PG8_SA(0, 0), a2, voffA);
            PG8_WAIT_V(8); PG8_WAIT_L(0); PG8_BAR; PG8_MMA(1, 0, At, B0); PG8_MMA(1, 1, At, B1); PG8_BAR; PG8_SCHED;
            PG8_LDB(B0, 1, 0); PG8_LDB(B1, 1, 1); PG8_SCHED; PG8_LDA(At, 1, 0); PG8_STAGE(PG8_SA(0, 1), a2 + hstepA, voffA);
            PG8_WAIT_V(8); PG8_WAIT_L(0); PG8_BAR; PG8_MMA(0, 0, At, B0); PG8_MMA(0, 1, At, B1); PG8_BAR; PG8_SCHED;
            PG8_LDA(At, 1, 1); PG8_STAGE(PG8_SB(1, 0), b3, voffB); PG8_STAGE(PG8_SB(1, 1), b3 + hstepB, voffB); PG8_STAGE(PG8_SA(1, 0), a3, voffA);
            PG8_WAIT_V(8); PG8_WAIT_L(0); PG8_BAR; PG8_MMA(1, 0, At, B0); PG8_MMA(1, 1, At, B1); PG8_BAR; PG8_SCHED;
            } else {
            PG8_LDB(B0, 0, 0); PG8_SCHED; PG8_LDA(At, 0, 0); PG8_STAGE(PG8_SA(1, 1), a1 + hstepA, voffA);
            PG8_WAIT_L(8); PG8_BAR; PG8_WAIT_L(0); PG8_MMA(0, 0, At, B0); PG8_BAR; PG8_SCHED;
            PG8_LDB(B1, 0, 1); PG8_STAGE(PG8_SB(0, 0), b2, voffB);
            PG8_BAR; PG8_WAIT_L(0); PG8_MMA(0, 1, At, B1); PG8_BAR;
            PG8_LDA(At, 0, 1); PG8_STAGE(PG8_SA(0, 0), a2, voffA);
            PG8_BAR; PG8_WAIT_L(0); PG8_MMA(1, 0, At, B0); PG8_BAR; PG8_SCHED;
            PG8_STAGE(PG8_SB(0, 1), b2 + hstepB, voffB);
            PG8_WAIT_V(6); PG8_BAR; PG8_MMA(1, 1, At, B1); PG8_BAR;
            PG8_LDB(B0, 1, 0); PG8_SCHED; PG8_LDA(At, 1, 0); PG8_STAGE(PG8_SA(0, 1), a2 + hstepA, voffA);
            PG8_WAIT_L(8); PG8_BAR; PG8_WAIT_L(0); PG8_MMA(0, 0, At, B0); PG8_BAR; PG8_SCHED;
            PG8_LDB(B1, 1, 1); PG8_STAGE(PG8_SB(1, 0), b3, voffB);
            PG8_BAR; PG8_WAIT_L(0); PG8_MMA(0, 1, At, B1); PG8_BAR;
            PG8_LDA(At, 1, 1); PG8_STAGE(PG8_SA(1, 0), a3, voffA);
            PG8_BAR; PG8_WAIT_L(0); PG8_MMA(1, 0, At, B0); PG8_BAR; PG8_SCHED;
            PG8_STAGE(PG8_SB(1, 1), b3 + hstepB, voffB);
            PG8_WAIT_V(6); PG8_BAR; PG8_MMA(1, 1, At, B1); PG8_BAR;
            }
        }
        if constexpr (ALIGN_EPI) { if (wr == 0) PG8_BAR; }
        E(acc, cur, wr, wc, fr, fq); S.done(cur);
        if (!has_next) break;
#pragma unroll
        for (int a = 0; a < 2; ++a)
#pragma unroll
            for (int b = 0; b < 2; ++b)
#pragma unroll
                for (int m = 0; m < 4; ++m)
#pragma unroll
                    for (int n = 0; n < 2; ++n) acc[a][b][m][n] = (f32x4){0.f, 0.f, 0.f, 0.f};
        cur = nxt; cA = nA; cB = nB; ++ui;
        if constexpr (ALIGN_EPI) { if (wr == 1) PG8_BAR; }
    }
    PG8_WAIT_V(0);
    if constexpr (!ALIGN_EPI) { if (wr == 0) PG8_BAR; }
    PG8_BAR;
#undef PG8_SA
#undef PG8_SB
#undef PG8_STAGE
#undef PG8_LDA
#undef PG8_LDB
#undef PG8_MMA
#undef PG8_WAIT_V
#undef PG8_WAIT_L
#undef PG8_BAR
#undef PG8_SCHED
}
}

struct AttnUnit {
    const bf16_t* Q; int ldq;
    const bf16_t* K; int ldk;
    const bf16_t* Kpe;
    const bf16_t* V; int ldv;
    const bf16_t* G;
    bf16_t* Y;
    int nt, ntreal, nfirst, base1, base2;
    float scale;
    int tq0;
    int ropeq;
    int qnorm, qrope;
    const float* qg;
    const float* rpb;
    const float* tab;
    const float* subln;
    float lam, omli;
};

__host__ __device__ __forceinline__ int attn_nunits(int sect, int rnd) {
    if (rnd == 0) return sect == 2 ? 512 : 256;
    return sect == 0 ? 128 : sect == 1 ? 256 : sect == 2 ? 256 : 0;
}
__device__ __forceinline__ AttnUnit make_unit(int sect, int rnd, int idx, int l, bf16_t* z, bf16_t* qb, bf16_t* kvb, bf16_t* y, const float* a_rpb, const float* tab, const float* subln, const float* cqn) {
    AttnUnit U; U.qnorm = 0; U.qrope = 0; U.qg = cqn + l * 128; U.Kpe = nullptr; U.tq0 = 0; U.ropeq = 0; U.rpb = nullptr; U.tab = tab; U.subln = subln + l * 128; U.lam = tab[TB_LAM + 2 * l]; U.omli = 1.0f - tab[TB_LAM + 2 * l + 1];
    int tok0, kq0, kk0, h, grp, nkeys; bool masked = false;
    if (rnd == 0) {
        int lb, qoff;
        if (sect == 2) { const int q16 = idx & 15; h = (idx >> 4) & 7; lb = idx >> 7; qoff = q16 * 128; } else { const int qblk = idx & 7; h = (idx >> 3) & 7; lb = idx >> 6; qoff = qblk * 256; }
        tok0 = NP + lb * LSEQ + qoff; kk0 = NP + lb * LKV; kq0 = kk0 + qoff; nkeys = LKV; U.tq0 = qoff;
        grp = sect == 0 ? 1 : sect == 1 ? 2 : sect == 2 ? 3 : 0;
        if (sect == 0) U.ropeq = 1;
        if (sect == 3) { masked = true; U.rpb = a_rpb + (size_t)(l * 8 + h) * 465; }
    } else {
        int pb, qoff = 0;
        if (sect == 2) { qoff = (idx & 1) * 128; h = (idx >> 1) & 7; pb = idx >> 4; grp = 3; }
        else if (sect == 0) { h = idx & 7; pb = idx >> 3; grp = 1; }
        else { const int i2 = idx & 127; h = i2 & 7; pb = i2 >> 3; grp = idx < 128 ? 2 : 0; }
        kk0 = pb * 256; tok0 = kk0 + qoff; kq0 = tok0; nkeys = PSEQ;
    }
    const bf16_t* zq = z + (size_t)kq0 * LDZ; const bf16_t* zk = z + (size_t)kk0 * LDZ; bf16_t* yq = y + (size_t)tok0 * DM;
    if (grp == 0) { U.Q = zq + ZC_AQ + h * 128; U.ldq = LDZ; U.K = zk + ZC_AK + h * 128; U.ldk = LDZ; U.V = zk + ZC_AV + h * 128; U.ldv = LDZ; U.scale = 0.08838834764831845f; U.G = zq + ZC_AZ + h * 128; U.Y = yq + h * 128; }
    else if (grp == 1) { U.Q = qb + (size_t)kq0 * LDQB + h * 192; U.ldq = LDQB; U.K = kvb + (size_t)kk0 * LDKVB + h * 256; U.ldk = LDKVB; U.Kpe = zk + ZC_BKPE; U.V = kvb + (size_t)kk0 * LDKVB + h * 256 + 128; U.ldv = LDKVB;
        U.scale = 0.07216878364870323f; U.G = zq + ZC_BZ + h * 128; U.Y = yq + 1024 + h * 128; }
    else if (grp == 2) { U.qnorm = 1; U.qrope = (rnd == 0); U.Q = zq + ZC_CQ + h * 128; U.ldq = LDZ; U.K = zk + ZC_CK + (h >> 2) * 128; U.ldk = LDZ; U.V = zk + ZC_CV + (h >> 2) * 128; U.ldv = LDZ; U.scale = 0.08838834764831845f; U.G = zq + ZC_CZ + h * 128; U.Y = yq + 2048 + h * 128; }
    else { U.qrope = (rnd == 0); U.Q = zq + ZC_DQ + h * 128; U.ldq = LDZ; U.K = zk + ZC_DK + h * 128; U.ldk = LDZ; U.V = zk + ZC_DV + h * 128; U.ldv = LDZ; U.scale = 0.125f; U.G = zq + ZC_DZ + h * 128; U.Y = yq + 3072 + h * 128; }
    if (masked) {
        const int r0 = U.tq0 >> 6; int lo = r0 - 4; lo = lo < 0 ? 0 : (lo > 24 ? 24 : lo); int hs = r0 + 3 - 4; hs = hs < 0 ? 0 : (hs > 24 ? 24 : hs); const int hiR = hs + 7;
        U.ntreal = 4 + (hiR - lo + 1); U.nt = (U.ntreal + 1) & ~1; U.nfirst = 4; U.base1 = 32; U.base2 = lo;
    } else { U.nt = nkeys / 64; U.ntreal = U.nt; U.nfirst = U.nt; U.base1 = 0; U.base2 = 0; }
    return U;
}

namespace att {
constexpr float THR = 8.f;
#define SBAR() __builtin_amdgcn_sched_barrier(0)
__device__ __forceinline__ int crow(int r, int hi) { return (r & 3) + 8 * (r >> 2) + 4 * hi; }
__device__ __forceinline__ float fma1(float a, float b, float c) { float d; asm("v_fma_f32 %0, %1, %2, %3" : "=v"(d) : "v"(a), "v"(b), "v"(c)); return d; }
template <bool FIRST>
__device__ __forceinline__ void partialSM(f32x16& p0, f32x16& p1, float& m_reg, float& alpha, float thr2) {
    float pmax = p0[0];
#pragma unroll
    for (int r = 1; r < 16; ++r) pmax = fmaxf(pmax, p0[r]);
#pragma unroll
    for (int r = 0; r < 16; ++r) pmax = fmaxf(pmax, p1[r]);
    { auto rr = __builtin_amdgcn_permlane32_swap(__float_as_uint(pmax), __float_as_uint(pmax), false, false);
      pmax = fmaxf(__uint_as_float(rr[0]), __uint_as_float(rr[1])); }
    alpha = 1.f;
    if (FIRST || !__all(pmax <= thr2)) {
        const float d = FIRST ? pmax : fmaxf(pmax, 0.f);
        if (!FIRST) alpha = __builtin_amdgcn_exp2f(-d);
        m_reg += d;
#pragma unroll
        for (int r = 0; r < 16; ++r) { p0[r] -= d; p1[r] -= d; }
    }
#pragma unroll
    for (int r = 0; r < 16; ++r) p0[r] = __builtin_amdgcn_exp2f(p0[r]);
}
__device__ __forceinline__ void finishSM(f32x16& p0, f32x16& p1, float alpha, float& l_reg, bf16x8& pa0, bf16x8& pa1, bf16x8& pa2, bf16x8& pa3) {
#pragma unroll
    for (int r = 0; r < 16; ++r) p1[r] = __builtin_amdgcn_exp2f(p1[r]);
    float ps = 0;
#pragma unroll
    for (int r = 0; r < 16; ++r) ps += p0[r];
#pragma unroll
    for (int r = 0; r < 16; ++r) ps += p1[r];
    { auto rr = __builtin_amdgcn_permlane32_swap(__float_as_uint(ps), __float_as_uint(ps), false, false);
      ps = __uint_as_float(rr[0]) + __uint_as_float(rr[1]); }
    l_reg = l_reg * alpha + ps;
#define PK4(P, BASE, OUT) do { u32x4 w = {cvt_pk_bf16(P[BASE + 0], P[BASE + 1]), cvt_pk_bf16(P[BASE + 2], P[BASE + 3]), cvt_pk_bf16(P[BASE + 4], P[BASE + 5]), cvt_pk_bf16(P[BASE + 6], P[BASE + 7])}; \
    OUT = *reinterpret_cast<bf16x8*>(&w); } while (0)
    PK4(p0, 0, pa0); PK4(p0, 8, pa1); PK4(p1, 0, pa2); PK4(p1, 8, pa3);
#undef PK4
}
template <int KW> __device__ __forceinline__ int kswz(int row, int colB) { return row * (KW * 2) + (colB ^ ((row & 7) << 4)); }
template <int OFF> __device__ __forceinline__ bf16x8 lds_rd128(int a) { bf16x8 r; asm volatile("ds_read_b128 %0, %1 offset:%2" : "=&v"(r) : "v"(a), "i"(OFF) : "memory"); return r; }
template <int N> __device__ __forceinline__ void lds_wait2(bf16x8& x, bf16x8& y) { asm volatile("s_waitcnt lgkmcnt(%2)" : "+v"(x), "+v"(y) : "n"(N) : "memory"); }
template <int KW, int KOFF, int D0> __device__ __forceinline__ void qkt_ld(bf16x8& b0, bf16x8& b1, const int (&ka)[4]) {
    constexpr int IMM = (D0 >> 2) * 128 + KOFF;
    b0 = lds_rd128<IMM>(ka[D0 & 3]); b1 = lds_rd128<IMM + 32 * KW * 2>(ka[D0 & 3]);
}
template <int DQ, int KW, int NQR, int KOFF, int D0> __device__ __forceinline__ void qkt_step(f32x16& p0, f32x16& p1, bf16x8 (&kb)[3][2], const int (&ka)[4], const bf16x8* qr, const char* qlds) {
    constexpr int ND0 = DQ / 16;
    if constexpr (D0 < ND0) {
        if constexpr (D0 + 2 < ND0) qkt_ld<KW, KOFF, D0 + 2>(kb[(D0 + 2) % 3][0], kb[(D0 + 2) % 3][1], ka);
        constexpr int AFTER = (ND0 - 1 - D0) < 2 ? (ND0 - 1 - D0) : 2;
        lds_wait2<2 * AFTER>(kb[D0 % 3][0], kb[D0 % 3][1]);
        bf16x8 q; if constexpr (D0 < NQR) q = qr[D0]; else q = *reinterpret_cast<const bf16x8*>(qlds + (D0 - NQR) * 8192);
        p0 = __builtin_amdgcn_mfma_f32_32x32x16_bf16(kb[D0 % 3][0], q, p0, 0, 0, 0);
        p1 = __builtin_amdgcn_mfma_f32_32x32x16_bf16(kb[D0 % 3][1], q, p1, 0, 0, 0);
        qkt_step<DQ, KW, NQR, KOFF, D0 + 1>(p0, p1, kb, ka, qr, qlds);
    }
}
template <int DQ, int KW, int NQR, int KOFF> __device__ __forceinline__ void qkt(f32x16& p0, f32x16& p1, const int (&ka)[4], const bf16x8* qr, const char* qlds, float cinit) {
#pragma unroll
    for (int r = 0; r < 16; ++r) { p0[r] = cinit; p1[r] = cinit; }
    bf16x8 kb[3][2];
    qkt_ld<KW, KOFF, 0>(kb[0][0], kb[0][1], ka); qkt_ld<KW, KOFF, 1>(kb[1][0], kb[1][1], ka);
    qkt_step<DQ, KW, NQR, KOFF, 0>(p0, p1, kb, ka, qr, qlds);
}
__device__ __forceinline__ void rope_pair(bf16x8& a, bf16x8& b, const float* tc, const float* ts) {
    const f32x4 c0 = *(const f32x4*)tc, c1 = *(const f32x4*)(tc + 4), s0 = *(const f32x4*)ts, s1 = *(const f32x4*)(ts + 4);
    const float cs[8] = {c0[0], c0[1], c0[2], c0[3], c1[0], c1[1], c1[2], c1[3]}, sn[8] = {s0[0], s0[1], s0[2], s0[3], s1[0], s1[1], s1[2], s1[3]};
    u32x4 ua = *reinterpret_cast<u32x4*>(&a), ub = *reinterpret_cast<u32x4*>(&b), oa, ob;
#pragma unroll
    for (int w = 0; w < 4; ++w) { const float x1l = bflo(ua[w]), x1h = bfhi(ua[w]), x2l = bflo(ub[w]), x2h = bfhi(ub[w]);
        oa[w] = pk2(x1l * cs[2 * w] - x2l * sn[2 * w], x1h * cs[2 * w + 1] - x2h * sn[2 * w + 1]);
        ob[w] = pk2(x2l * cs[2 * w] + x1l * sn[2 * w], x2h * cs[2 * w + 1] + x1h * sn[2 * w + 1]); }
    a = *reinterpret_cast<bf16x8*>(&oa); b = *reinterpret_cast<bf16x8*>(&ob);
}
__device__ __forceinline__ int v_st(int k, int c) { const int kk = (k & ~0xC) | ((k & 4) << 1) | ((k & 8) >> 1); return ((kk >> 3) * 4 + (c >> 5)) * 512 + ((kk & 7) * 32 + (c & 31)) * 2; }
__device__ __forceinline__ int v_rd_base(int lane) { return ((lane & 3) << 3) | (((lane >> 2) & 3) << 6) | (((lane >> 4) & 1) << 5) | (((lane >> 5) & 1) << 11); }
constexpr int v_rd_off(int d0, int ks, int grp) { return d0 * 512 + ks * 4096 + grp * 256; }
template <int OFF> __device__ __forceinline__ s16x4 tr_read(int vb) {
    s16x4 r; asm volatile("ds_read_b64_tr_b16 %0, %1 offset:%2" : "=&v"(r) : "v"(vb), "i"(OFF) : "memory"); return r;
}
template <int OFF> __device__ __forceinline__ float lds_rd32(int a) { float r; asm volatile("ds_read_b32 %0, %1 offset:%2" : "=&v"(r) : "v"(a), "i"(OFF) : "memory"); return r; }
template <int BASE> __device__ __forceinline__ void maskblk(f32x16& P, int ra, unsigned vm) {
    float b[16];
#define RD_(r) b[r] = lds_rd32<(BASE + ((r) & 3) + 8 * ((r) >> 2)) * 4>(ra);
    RD_(0) RD_(1) RD_(2) RD_(3) RD_(4) RD_(5) RD_(6) RD_(7) RD_(8) RD_(9) RD_(10) RD_(11) RD_(12) RD_(13) RD_(14) RD_(15)
#undef RD_
    asm volatile("s_waitcnt lgkmcnt(0)" : "+v"(b[0]), "+v"(b[1]), "+v"(b[2]), "+v"(b[3]), "+v"(b[4]), "+v"(b[5]), "+v"(b[6]), "+v"(b[7]), "+v"(b[8]), "+v"(b[9]), "+v"(b[10]), "+v"(b[11]), "+v"(b[12]), "+v"(b[13]), "+v"(b[14]), "+v"(b[15]) :: "memory");
#pragma unroll
    for (int r = 0; r < 16; ++r) P[r] = ((vm >> r) & 1u) ? P[r] + b[r] : -1e30f;
}
template <int D0> __device__ __forceinline__ void pv_one(f32x16& od, int vb, bf16x8 pa0, bf16x8 pa1, bf16x8 pa2, bf16x8 pa3) {
    s16x4 l0 = tr_read<v_rd_off(D0, 0, 0)>(vb), h0 = tr_read<v_rd_off(D0, 0, 1)>(vb), l1 = tr_read<v_rd_off(D0, 1, 0)>(vb), h1 = tr_read<v_rd_off(D0, 1, 1)>(vb);
    s16x4 l2 = tr_read<v_rd_off(D0, 2, 0)>(vb), h2 = tr_read<v_rd_off(D0, 2, 1)>(vb), l3 = tr_read<v_rd_off(D0, 3, 0)>(vb), h3 = tr_read<v_rd_off(D0, 3, 1)>(vb);
    asm volatile("s_waitcnt lgkmcnt(0)" : "+v"(l0), "+v"(h0), "+v"(l1), "+v"(h1), "+v"(l2), "+v"(h2), "+v"(l3), "+v"(h3) :: "memory");
#define PK(L, H) (bf16x8){L[0], L[1], L[2], L[3], H[0], H[1], H[2], H[3]}
    od = __builtin_amdgcn_mfma_f32_32x32x16_bf16(PK(l0, h0), pa0, od, 0, 0, 0);
    od = __builtin_amdgcn_mfma_f32_32x32x16_bf16(PK(l1, h1), pa1, od, 0, 0, 0);
    od = __builtin_amdgcn_mfma_f32_32x32x16_bf16(PK(l2, h2), pa2, od, 0, 0, 0);
    od = __builtin_amdgcn_mfma_f32_32x32x16_bf16(PK(l3, h3), pa3, od, 0, 0, 0);
#undef PK
}
__device__ __forceinline__ void pv_d0(f32x16* o, int vb, bf16x8 pa0, bf16x8 pa1, bf16x8 pa2, bf16x8 pa3) {
    pv_one<0>(o[0], vb, pa0, pa1, pa2, pa3); pv_one<1>(o[1], vb, pa0, pa1, pa2, pa3); pv_one<2>(o[2], vb, pa0, pa1, pa2, pa3); pv_one<3>(o[3], vb, pa0, pa1, pa2, pa3);
}

struct SectCtx { int sect, rnd, l, nu; unsigned* qc; bf16_t* z; bf16_t* qb; bf16_t* kvb; bf16_t* y; const float* a_rpb; const float* tab; const float* subln; const float* cqn; };
struct StOff { int vo0, vts, v32, ko0, k32, ktsn; };
template <int DQ, int KW, bool MASK, bool DPAIR>
__device__ __forceinline__ void attn_section(const SectCtx& C, char* lds, int wv) {
    constexpr int SHM_V = 16384, SHM_K = 64 * KW * 2, ND0 = DQ / 16, NKC = KW / 64, SD = 1;
    int lane_ = lane_id(); asm volatile("" : "+v"(lane_));
    const int wid = wv, lane = lane_, tid = wid * 64 + lane, r32 = lane & 31, hi = lane >> 5;
    const int sub = DPAIR ? (wid >> 2) : 0, rowbase = DPAIR ? (wid & 3) * 32 : wid * 32, cofs = sub * 128;
    const bool leader = (wid == 0) && (lane == 0);
    constexpr bool V3 = (KW != 192) && !MASK;
    constexpr int NVB = V3 ? 3 : 2;
    char* V_lds = lds; char* K_lds = lds + NVB * SHM_V;
    constexpr int WSF_OFF = ATT_WSF_OFF, RPB_OFF = ATT_RPB_OFF, QL_OFF = NVB * SHM_V + 2 * SHM_K;
    constexpr int GT_ROWB = 272, GT_OFF = DPAIR ? 65536 : 0, GCH = DPAIR ? 4 : 8;
        float* rpb_l = (float*)(lds + RPB_OFF);
    volatile unsigned* MQ = (volatile unsigned*)(lds + MISC_OFF);
    constexpr int NQR = DQ == 192 ? 6 : ND0;
    const char* qlds = lds + QL_OFF + tid * 16;
    const int sr = tid >> 4, sc = (tid & 15) * 8, vst0 = v_st(sr, sc);
    const int kst0 = kswz<KW>(sr, sc * 2);
    const int kop = (tid >> 3) * LDZ + (tid & 7) * 8, kstp = kswz<KW>(tid >> 3, (16 + (tid & 7)) * 16), ktsp = 64 * LDZ;
    (void)kop; (void)kstp; (void)ktsp;
    const int vb0 = (int)(uintptr_t)V_lds + v_rd_base(lane);
    int ka[4];
#pragma unroll
    for (int i = 0; i < 4; ++i) ka[i] = (int)(uintptr_t)K_lds + r32 * (KW * 2) + cofs + ((i * 32 + hi * 16) ^ ((r32 & 7) << 4));
    struct Slot { bf16x8 vs0, vs1, ks[NKC]; } sl[SD];
#define MKOFF(UU) StOff{sr * (UU).ldv + sc, 64 * (UU).ldv, 32 * (UU).ldv, sr * (UU).ldk + sc, 32 * (UU).ldk, 64 * (UU).ldk}
#define KT_OFX(UU, j) ((j) < (UU).nfirst ? (UU).base1 + (j) : (UU).base2 + (j) - (UU).nfirst)
#define SLOADX(UU, OF, i, j) do { const int kt_ = KT_OFX(UU, j); sl[i].vs0 = *reinterpret_cast<const bf16x8*>((UU).V + ((OF).vo0 + kt_ * (OF).vts)); sl[i].vs1 = *reinterpret_cast<const bf16x8*>((UU).V + ((OF).vo0 + (kt_ * (OF).vts + (OF).v32))); \
    if constexpr (KW >= 128) { sl[i].ks[0] = *reinterpret_cast<const bf16x8*>((UU).K + ((OF).ko0 + kt_ * (OF).ktsn)); sl[i].ks[1] = *reinterpret_cast<const bf16x8*>((UU).K + ((OF).ko0 + (kt_ * (OF).ktsn + (OF).k32))); } \
    if constexpr (KW == 192) sl[i].ks[2] = *reinterpret_cast<const bf16x8*>((UU).Kpe + (kop + kt_ * ktsp)); } while (0)
#define QLOADX(UU, R32_, HI_) do { const bf16_t* Qw_ = (UU).Q + ((rowbase + (R32_)) * (UU).ldq + sub * 64 + (HI_) * 8); \
    _Pragma("unroll") for (int d0 = 0; d0 < ND0; ++d0) qr[d0] = *reinterpret_cast<const bf16x8*>(Qw_ + d0 * 16); \
    if constexpr (MASK) { if (tid < 465) p_rpb = (UU).rpb[tid]; } } while (0)
#define KT_OF(j) KT_OFX(U, j)
#define SLOAD(i, j) SLOADX(U, of, i, j)
#define SWRITE(b, vo, i) do { *(bf16x8*)(V_lds + (vo) + vst0) = sl[i].vs0; *(bf16x8*)(V_lds + (vo) + vst0 + 8192) = sl[i].vs1; \
    *(bf16x8*)(K_lds + (b) * SHM_K + kst0) = sl[i].ks[0]; *(bf16x8*)(K_lds + (b) * SHM_K + kst0 + 32 * KW * 2) = sl[i].ks[1]; \
    if constexpr (KW == 192) *(bf16x8*)(K_lds + (b) * SHM_K + kstp) = sl[i].ks[2]; } while (0)
#define SWAIT() asm volatile("s_waitcnt vmcnt(0)" ::: "memory")
#define RESC(a) do { if (__any((a) < 1.f)) { _Pragma("unroll") for (int d = 0; d < 4; ++d) _Pragma("unroll") for (int r = 0; r < 16; ++r) o[d][r] *= (a); } } while (0)
#define MASKB(P0, P1, j) do { if constexpr (MASK) { const int kt_ = KT_OF(j); \
    if ((j) >= U.ntreal || (kt_ < 32 && (kt_ < srw || kt_ > srw + 7))) { _Pragma("unroll") for (int r = 0; r < 16; ++r) { P0[r] = -1e30f; P1[r] = -1e30f; } } \
    else if (kt_ < 32) { const int ra_ = (int)(uintptr_t)rpb_l + ((kt_ - qrw + 7) * 31 + 15 - qc + 4 * hi) * 4;     \
        maskblk<0>(P0, ra_, vm0); maskblk<32>(P1, ra_, vm1); } } } while (0)
#define MKUNIT(idx_) make_unit(C.sect, C.rnd, (idx_), C.l, C.z, C.qb, C.kvb, C.y, C.a_rpb, C.tab, C.subln, C.cqn)
    if (leader) MQ[16] = atomicAdd(C.qc, 1u);
    __syncthreads(); const int idx0 = __builtin_amdgcn_readfirstlane((int)MQ[16]); __syncthreads();
    if (idx0 >= C.nu) return;
    AttnUnit U = MKUNIT(idx0); StOff of = MKOFF(U);
    bf16x8 qr[ND0]; float p_rpb = 0.f;
    QLOADX(U, r32, hi); SLOADX(U, of, 0, 0);
    for (;;) {
        unsigned r_next = 0u; if (leader) r_next = atomicAdd(C.qc, 1u);
        const float Cc = U.scale * 1.4426950408889634f, thr2 = THR * 1.4426950408889634f;
        float m_reg = 0.f, l_reg = 0; f32x16 o[4] = {};
#define QSCALE() do { _Pragma("unroll") for (int d0 = 0; d0 < ND0; ++d0) { u32x4 w_ = *reinterpret_cast<u32x4*>(&qr[d0]); \
            w_.x = cvt_pk_bf16(bflo(w_.x) * Cc, bfhi(w_.x) * Cc); w_.y = cvt_pk_bf16(bflo(w_.y) * Cc, bfhi(w_.y) * Cc); w_.z = cvt_pk_bf16(bflo(w_.z) * Cc, bfhi(w_.z) * Cc); w_.w = cvt_pk_bf16(bflo(w_.w) * Cc, bfhi(w_.w) * Cc); \
            qr[d0] = *reinterpret_cast<bf16x8*>(&w_); } } while (0)
        if constexpr (DQ == 192) {
            if (U.ropeq) { const int t = U.tq0 + rowbase + r32, prow = t >> 6, pcol = t & 63;
                rope_pair(qr[8], qr[9], U.tab + TB_C64 + prow * 16 + hi * 8, U.tab + TB_S64 + prow * 16 + hi * 8);
                rope_pair(qr[10], qr[11], U.tab + TB_C64 + pcol * 16 + hi * 8, U.tab + TB_S64 + pcol * 16 + hi * 8); }
            QSCALE();
            char* qw = lds + QL_OFF + tid * 16;
#pragma unroll
            for (int d0 = NQR; d0 < ND0; ++d0) *(bf16x8*)(qw + (d0 - NQR) * 8192) = qr[d0];
        }
        if constexpr (DQ == 128 && !MASK && !DPAIR) {
            if (U.qnorm) { int h8 = hi * 8; asm volatile("" : "+v"(h8));
                float xf[8][8]; float ss = 0.f;
#pragma unroll
                for (int d0 = 0; d0 < 8; ++d0) { const u32x4 w = *reinterpret_cast<const u32x4*>(&qr[d0]);
                    xf[d0][0] = bflo(w.x); xf[d0][1] = bfhi(w.x); xf[d0][2] = bflo(w.y); xf[d0][3] = bfhi(w.y); xf[d0][4] = bflo(w.z); xf[d0][5] = bfhi(w.z); xf[d0][6] = bflo(w.w); xf[d0][7] = bfhi(w.w);
#pragma unroll
                    for (int e = 0; e < 8; ++e) ss += xf[d0][e] * xf[d0][e]; }
                { auto rr = __builtin_amdgcn_permlane32_swap(__float_as_uint(ss), __float_as_uint(ss), false, false); ss = __uint_as_float(rr[0]) + __uint_as_float(rr[1]); }
                const float rstd = 1.0f / sqrtf(ss * (1.0f / 128.0f) + EPS);
#pragma unroll
                for (int d0 = 0; d0 < 8; ++d0) { const f32x4 g0 = *(const f32x4*)(U.qg + d0 * 16 + h8), g1 = *(const f32x4*)(U.qg + d0 * 16 + h8 + 4);
#pragma unroll
                    for (int e = 0; e < 4; ++e) { xf[d0][e] = xf[d0][e] * rstd * g0[e]; xf[d0][4 + e] = xf[d0][4 + e] * rstd * g1[e]; } }
                if (U.qrope) { const int t = U.tq0 + rowbase + r32, prow = t >> 6, pcol = t & 63;
#pragma unroll
                    for (int pr = 0; pr < 4; ++pr) { const int da = (pr >> 1) * 4 + (pr & 1), db = da + 2, pos = pr < 2 ? prow : pcol, fb = (pr & 1) * 16 + h8;
                        const f32x4 c0 = *(const f32x4*)(U.tab + TB_C128 + pos * 32 + fb), c1 = *(const f32x4*)(U.tab + TB_C128 + pos * 32 + fb + 4), s0 = *(const f32x4*)(U.tab + TB_S128 + pos * 32 + fb), s1 = *(const f32x4*)(U.tab + TB_S128 + pos * 32 + fb + 4);
#pragma unroll
                        for (int e = 0; e < 8; ++e) { const float cs = e < 4 ? c0[e & 3] : c1[e & 3], sn = e < 4 ? s0[e & 3] : s1[e & 3]; const float x1 = xf[da][e], x2 = xf[db][e];
                            xf[da][e] = x1 * cs - x2 * sn; xf[db][e] = x2 * cs + x1 * sn; } } }
#pragma unroll
                for (int d0 = 0; d0 < 8; ++d0) { u32x4 w; w.x = pk2(xf[d0][0], xf[d0][1]); w.y = pk2(xf[d0][2], xf[d0][3]); w.z = pk2(xf[d0][4], xf[d0][5]); w.w = pk2(xf[d0][6], xf[d0][7]); qr[d0] = *reinterpret_cast<bf16x8*>(&w); }
            }
        }
        if constexpr (DPAIR) {
            if (U.qrope) { const int t = U.tq0 + rowbase + r32, prow = t >> 6, pcol = t & 63;
                rope_pair(qr[0], qr[1], U.tab + TB_C64 + prow * 16 + hi * 8, U.tab + TB_S64 + prow * 16 + hi * 8);
                rope_pair(qr[2], qr[3], U.tab + TB_C64 + pcol * 16 + hi * 8, U.tab + TB_S64 + pcol * 16 + hi * 8); }
        }
        if constexpr (DQ != 192) QSCALE();
#undef QSCALE
        int qrw = 0, srw = 0, qc = 0; unsigned vm0 = 0, vm1 = 0;
        if constexpr (MASK) {
            qrw = (U.tq0 >> 6) + (wid >> 1); srw = qrw - 4; srw = srw < 0 ? 0 : (srw > 24 ? 24 : srw);
            qc = 32 * (wid & 1) + r32; int scq = qc - 8; scq = scq < 0 ? 0 : (scq > 48 ? 48 : scq);
#pragma unroll
            for (int r = 0; r < 16; ++r) { const int k0 = crow(r, hi), k1 = 32 + k0; vm0 |= (unsigned)(k0 >= scq && k0 < scq + 16) << r; vm1 |= (unsigned)(k1 >= scq && k1 < scq + 16) << r; }
            if (tid < 465) rpb_l[tid] = p_rpb * 1.4426950408889634f;
        }
        f32x16 pA0, pA1, pB0, pB1; float alA, alB; bf16x8 pa0, pa1, pa2, pa3; const int NT = U.nt;
        SWRITE(0, 0, 0); SLOAD(0, 1); __syncthreads();
        qkt<DQ, KW, NQR, 0>(pA0, pA1, ka, qr, qlds, 0.f); MASKB(pA0, pA1, 0); partialSM<true>(pA0, pA1, m_reg, alA, thr2);
        SWAIT(); if (leader) MQ[17] = r_next; SWRITE(1, SHM_V, 0); __syncthreads();
        int v0 = 0;
#define VNX(v) (V3 ? ((v) + SHM_V == 3 * SHM_V ? 0 : (v) + SHM_V) : ((v) ^ SHM_V))
        for (int j = 1; j + 1 < NT; j += 2) {
            SBAR(); qkt<DQ, KW, NQR, SHM_K>(pB0, pB1, ka, qr, qlds, -m_reg);
            finishSM(pA0, pA1, alA, l_reg, pa0, pa1, pa2, pa3); SBAR();
            SLOAD(0, j + 1); SBAR();
            pv_d0(o, vb0 + v0, pa0, pa1, pa2, pa3); MASKB(pB0, pB1, j); partialSM<false>(pB0, pB1, m_reg, alB, thr2);
            if constexpr (!V3) __syncthreads();
            SWAIT(); SWRITE(0, (V3 ? VNX(VNX(v0)) : v0), 0);
            RESC(alB); __syncthreads();
            SBAR(); qkt<DQ, KW, NQR, 0>(pA0, pA1, ka, qr, qlds, -m_reg);
            finishSM(pB0, pB1, alB, l_reg, pa0, pa1, pa2, pa3); SBAR();
            SLOAD(0, j + 2); SBAR();
            pv_d0(o, vb0 + VNX(v0), pa0, pa1, pa2, pa3); MASKB(pA0, pA1, j + 1); partialSM<false>(pA0, pA1, m_reg, alA, thr2);
            if constexpr (!V3) __syncthreads();
            SWAIT(); SWRITE(1, (V3 ? v0 : VNX(v0)), 0);
            RESC(alA); __syncthreads();
            if constexpr (V3) v0 = VNX(VNX(v0));
        }
        bf16x8 gch[GCH];
        SBAR(); qkt<DQ, KW, NQR, SHM_K>(pB0, pB1, ka, qr, qlds, -m_reg);
        finishSM(pA0, pA1, alA, l_reg, pa0, pa1, pa2, pa3); SBAR();
        pv_d0(o, vb0 + v0, pa0, pa1, pa2, pa3); MASKB(pB0, pB1, NT - 1); partialSM<false>(pB0, pB1, m_reg, alB, thr2);
        RESC(alB);
        finishSM(pB0, pB1, alB, l_reg, pa0, pa1, pa2, pa3); SBAR();
        pv_d0(o, vb0 + VNX(v0), pa0, pa1, pa2, pa3);
        int tide = tid; asm volatile("" : "+v"(tide));
        const int g_off = (tide >> 4) * LDZ + (tide & 15) * 8, t_off = GT_OFF + (tide >> 4) * GT_ROWB + (tide & 15) * 16;
#pragma unroll
        for (int i = 0; i < GCH; ++i) gch[i] = *reinterpret_cast<const bf16x8*>(U.G + (g_off + i * 32 * LDZ));
        const int nidx = __builtin_amdgcn_readfirstlane((int)MQ[17]); const bool has_next = nidx < C.nu;
        AttnUnit Un = U; StOff ofn = of;
        if (has_next) { Un = MKUNIT(nidx); ofn = MKOFF(Un); }
        QLOADX(Un, tide & 31, (tide >> 5) & 1); SLOADX(Un, ofn, 0, 0);
        SBAR();
        { const float rl = __builtin_amdgcn_rcpf(l_reg);
#pragma unroll
          for (int d0 = 0; d0 < 4; ++d0)
#pragma unroll
              for (int r = 0; r < 16; ++r) o[d0][r] *= rl; }
        __syncthreads();
        char* tl = lds + ((rowbase + r32) * GT_ROWB + GT_OFF + hi * 8);
        if constexpr (!DPAIR) {
#pragma unroll
            for (int i = 0; i < GCH; ++i) *(bf16x8*)(lds + t_off + i * 32 * GT_ROWB) = gch[i];
            __syncthreads();
#pragma unroll
            for (int d0 = 0; d0 < 4; ++d0)
#pragma unroll
                for (int rg = 0; rg < 4; ++rg) { u32x2* p = (u32x2*)(tl + d0 * 64 + rg * 16); const u32x2 g = *p; u32x2 w;
                    w.x = cvt_pk_bf16(o[d0][4 * rg] * silu_f(bflo(g.x)), o[d0][4 * rg + 1] * silu_f(bfhi(g.x))); w.y = cvt_pk_bf16(o[d0][4 * rg + 2] * silu_f(bflo(g.y)), o[d0][4 * rg + 3] * silu_f(bfhi(g.y))); *p = w; }
        } else {
            float* xch = (float*)lds + ((wid & 3) * 64 + lane);
            if (sub == 1) {
#pragma unroll
                for (int d0 = 0; d0 < 4; ++d0)
#pragma unroll
                    for (int r = 0; r < 16; ++r) xch[(d0 * 16 + r) * 256] = o[d0][r];
            }
#pragma unroll
            for (int i = 0; i < GCH; ++i) *(bf16x8*)(lds + t_off + i * 32 * GT_ROWB) = gch[i];
            __syncthreads();
            if (sub == 0) {
                const float lam = U.lam; float ss = 0.f;
#pragma unroll
                for (int d0 = 0; d0 < 4; ++d0)
#pragma unroll
                    for (int r = 0; r < 16; ++r) { const float od = o[d0][r] - lam * xch[(d0 * 16 + r) * 256]; o[d0][r] = od; ss += od * od; }
                { auto rr = __builtin_amdgcn_permlane32_swap(__float_as_uint(ss), __float_as_uint(ss), false, false); ss = __uint_as_float(rr[0]) + __uint_as_float(rr[1]); }
                const float rstd = U.omli / sqrtf(ss * (1.0f / 128.0f) + EPS);
                const float* gsl = U.subln + hi * 4;
#pragma unroll
                for (int d0 = 0; d0 < 4; ++d0)
#pragma unroll
                    for (int rg = 0; rg < 4; ++rg) { u32x2* p = (u32x2*)(tl + d0 * 64 + rg * 16); const u32x2 g = *p; const f32x4 gl = *(const f32x4*)(gsl + d0 * 32 + rg * 8); u32x2 w;
                        w.x = cvt_pk_bf16(o[d0][4 * rg] * rstd * gl[0] * silu_f(bflo(g.x)), o[d0][4 * rg + 1] * rstd * gl[1] * silu_f(bfhi(g.x)));
                        w.y = cvt_pk_bf16(o[d0][4 * rg + 2] * rstd * gl[2] * silu_f(bflo(g.y)), o[d0][4 * rg + 3] * rstd * gl[3] * silu_f(bfhi(g.y))); *p = w; }
            }
        }
        __syncthreads();
        { bf16_t* yb = U.Y + ((tide >> 4) * DM + (tide & 15) * 8);
#pragma unroll
          for (int i = 0; i < GCH; ++i) *reinterpret_cast<bf16x8*>(yb + i * 32 * DM) = *(const bf16x8*)(lds + t_off + i * 32 * GT_ROWB); }
        __syncthreads();
        if (!has_next) break;
        U = Un; of = ofn;
    }
#undef MKOFF
#undef KT_OFX
#undef SLOADX
#undef QLOADX
#undef KT_OF
#undef SLOAD
#undef SWRITE
#undef VNX
#undef SWAIT
#undef RESC
#undef MASKB
#undef MKUNIT
}
}

#define XB_TMO      128
#define XB_XCNT(j)  (256  + 64 * (j))
#define XB_XSUB(j)  (1280 + 64 * (j))
#define XB_XGEN(j)  (2304 + 64 * (j))
#define XB_TOP      3328
#define XB_TOPGEN   3392
#define XCD_BAR_WORDS 3456
#define XB_SPIN_CAP (1u << 22)
__device__ __forceinline__ unsigned xb_ld(unsigned* p)              { return __hip_atomic_load(p, __ATOMIC_RELAXED, __HIP_MEMORY_SCOPE_AGENT); }
__device__ __forceinline__ unsigned xb_add(unsigned* p, unsigned v) { return __hip_atomic_fetch_add(p, v, __ATOMIC_RELAXED, __HIP_MEMORY_SCOPE_AGENT); }
__device__ __forceinline__ unsigned xb_xcc_id() { return (unsigned)__builtin_amdgcn_s_getreg((3 << 11) | 20) & 0xFu; }
#define XB_SPIN(cond, bar) do { unsigned _sp = 0; while (cond) { __builtin_amdgcn_s_sleep(1); \
    if ((++_sp & 255u) == 0u) { if (xb_ld(&(bar)[XB_TMO])) break; if (_sp > XB_SPIN_CAP) { atomicAdd(&(bar)[XB_TMO], 1u); break; } } } } while (0)
struct XcdBarrier { unsigned* bar; unsigned x; volatile LAS unsigned* st; };
__device__ __forceinline__ XcdBarrier xcd_barrier_post(unsigned* bar, volatile LAS unsigned* st, bool leader) {
    XcdBarrier b; b.bar = bar; b.x = xb_xcc_id(); b.st = st;
    if (leader) (void)xb_add(&bar[XB_XCNT(b.x)], 1u);
    return b;
}
__device__ __forceinline__ void xcd_barrier_complete(unsigned* bar, unsigned x, unsigned& nloc, unsigned& nx) {
    const unsigned G = gridDim.x * gridDim.y * gridDim.z;
    unsigned sum, cnt, mine, sp = 0u;
    for (;;) {
        sum = 0u; cnt = 0u; mine = 0u;
#pragma unroll
        for (unsigned j = 0; j < 16; ++j) { const unsigned c = xb_ld(&bar[XB_XCNT(j)]); sum += c; cnt += (c > 0u) ? 1u : 0u; mine = (j == x) ? c : mine; }
        if (sum == G) break;
        __builtin_amdgcn_s_sleep(1);
        if ((++sp & 255u) == 0u) { if (xb_ld(&bar[XB_TMO])) break; if (sp > XB_SPIN_CAP) { atomicAdd(&bar[XB_TMO], 1u); break; } }
    }
    nloc = mine > 0u ? mine : 1u; nx = cnt > 0u ? cnt : 1u;
}
__device__ __forceinline__ void xcd_barrier(const XcdBarrier& b, bool leader) {
    asm volatile("s_waitcnt vmcnt(0)" ::: "memory");
    __syncthreads();
    if (leader) {
        unsigned* bar = b.bar; asm volatile("" : "+s"(bar)); bar = GLOBAL_PTR(unsigned, bar);
        const unsigned bx = xb_xcc_id();
        __builtin_amdgcn_s_waitcnt(0);
        unsigned nloc = b.st[0], nx = b.st[1];
        if (nloc == 0u) { xcd_barrier_complete(bar, bx, nloc, nx); b.st[0] = nloc; b.st[1] = nx; }
        const unsigned old = xb_add(&bar[XB_XSUB(bx)], 1u);
        const unsigned gen = old / nloc;
        if (old + 1u == (gen + 1u) * nloc) {
            __builtin_amdgcn_fence(__ATOMIC_RELEASE, "agent");
            asm volatile("s_waitcnt vmcnt(0)" ::: "memory");
            const unsigned og = xb_add(&bar[XB_TOP], 1u);
            const unsigned tg = og / nx;
            if (og + 1u == (tg + 1u) * nx) xb_add(&bar[XB_TOPGEN], 1u);
            else XB_SPIN(xb_ld(&bar[XB_TOPGEN]) == tg, bar);
            __builtin_amdgcn_fence(__ATOMIC_ACQUIRE, "agent");
            xb_add(&bar[XB_XGEN(bx)], 1u);
            asm volatile("s_waitcnt vmcnt(0)" ::: "memory");
        } else {
            XB_SPIN(xb_ld(&bar[XB_XGEN(bx)]) == gen, bar);
            __builtin_amdgcn_fence(__ATOMIC_ACQUIRE, "agent");
            asm volatile("s_waitcnt vmcnt(0)" ::: "memory");
        }
    }
    __syncthreads();
}

struct Params { const float* in[30]; float* out; unsigned char* ws; int ph_lo, ph_hi; };
#define PIN(i) GLOBAL_PTR(const float, P.in[i])
typedef const __attribute__((address_space(4))) Params* KargPtr;
#define KARGS_P() KargPtr kp_ = (KargPtr)__builtin_amdgcn_kernarg_segment_ptr(); asm volatile("" : "+s"(kp_)); const __attribute__((address_space(4))) Params& P = *kp_
enum { I_XP = 0, I_XS, I_CAK, I_CAV, I_CBCKV, I_CBKPE, I_CCK, I_CCV, I_CDK, I_CDV, I_C, I_CCTX, I_NORMG, I_WADA, I_BADA, I_WIN, I_WOUT, I_RPB, I_BQN, I_WUQ, I_BKVN, I_WUKV,
       I_CQN, I_CKN, I_LQ1, I_LK1, I_LQ2, I_LK2, I_SUBLN, I_FNG };

__device__ __forceinline__ void transpose_item(const float* __restrict__ W, int ldw, int k0, int nsrc0, bf16_t* __restrict__ WT, int K, int ndst0, LAS unsigned* scr, int lane, const float* kg = nullptr) {
    const int kk = lane >> 4, n4 = (lane & 15) * 4;
    const float* src = W + (size_t)(k0 + 2 * kk) * ldw + nsrc0 + n4;
    f32x4 a[8], b[8];
#pragma unroll
    for (int i = 0; i < 8; ++i) { a[i] = __builtin_nontemporal_load((const f32x4*)(src + (size_t)(8 * i) * ldw)); b[i] = __builtin_nontemporal_load((const f32x4*)(src + (size_t)(8 * i + 1) * ldw)); }
    if (kg) {
#pragma unroll
        for (int i = 0; i < 8; ++i) { a[i] = a[i] * kg[k0 + 2 * kk + 8 * i]; b[i] = b[i] * kg[k0 + 2 * kk + 8 * i + 1]; } }
#pragma unroll
    for (int i = 0; i < 8; ++i) { u32x4 w; w.x = pk2(a[i][0], b[i][0]); w.y = pk2(a[i][1], b[i][1]); w.z = pk2(a[i][2], b[i][2]); w.w = pk2(a[i][3], b[i][3]);
        *(LAS u32x4*)(scr + (i * 4 + kk) * 68 + n4) = w; }
    LDS_WAIT(); asm volatile("" ::: "memory");
    const int kp4 = (lane & 7) * 4;
#pragma unroll
    for (int j = 0; j < 8; ++j) { const int n = (lane >> 3) + 8 * j; const LAS unsigned* sp = scr + kp4 * 68 + n;
        u32x4 o; o.x = sp[0]; o.y = sp[68]; o.z = sp[136]; o.w = sp[204];
        *(u32x4*)(WT + (size_t)(ndst0 + n) * K + k0 + kp4 * 2) = o; }
    LDS_WAIT(); asm volatile("" ::: "memory");
}

#define PH_WS() unsigned char* ws = P.ws; asm volatile("" : "+s"(ws)); ws = GLOBAL_PTR(unsigned char, ws)
#define PH_KWS() KARGS_P(); PH_WS()
#define PH_IDS() int lane_ = lane_id(); asm volatile("" : "+v"(lane_)); const int lane = lane_, wave = wv, NGW = gridDim.x * NWAVES, gw = blockIdx.x * NWAVES + wave; (void)wave
__device__ __forceinline__ void ph_prologue(LAS unsigned char* lds, bool gemv, int wv) {
    KARGS_P(); PH_IDS(); PH_WS();
    if (gemv) for (int it = blockIdx.x; it < 256; it += gridDim.x) {
        const int l = it >> 7, rch = (it >> 4) & 7, cb = it & 15, dch = rch * 8 + wave;
        LAS float* sv = (LAS float*)(lds + wave * 2048);
        LAS float* accl = (LAS float*)(lds + 16384);
        for (int i = wave * 64 + lane; i < 3840; i += NTHR) accl[i] = 0.f;
        { const int d = dch * 64 + lane; sv[lane * 8] = silu_f(PIN(I_CCTX)[d]);
#pragma unroll
          for (int v = 1; v < 5; ++v) sv[lane * 8 + v] = silu_f(PIN(I_C)[(v - 1) * DM + d]); }
        __syncthreads();
        const float* W = PIN(I_WADA) + (size_t)l * DM * 12288 + (size_t)(dch * 64) * 12288 + cb * 768 + lane * 4;
        f32x4 acc[5][3];
#pragma unroll
        for (int v = 0; v < 5; ++v)
#pragma unroll
            for (int j = 0; j < 3; ++j) acc[v][j] = (f32x4){0.f, 0.f, 0.f, 0.f};
        for (int r0 = 0; r0 < 64; r0 += 8) {
            f32x4 w[8][3];
#pragma unroll
            for (int rr = 0; rr < 8; ++rr)
#pragma unroll
                for (int j = 0; j < 3; ++j) w[rr][j] = __builtin_nontemporal_load((const f32x4*)(W + (size_t)(r0 + rr) * 12288 + j * 256));
            __builtin_amdgcn_sched_barrier(0);
#pragma unroll
            for (int rr = 0; rr < 8; ++rr) { const f32x4 s0 = *(const LAS f32x4*)(sv + (r0 + rr) * 8); const float s4 = sv[(r0 + rr) * 8 + 4];
#pragma unroll
                for (int j = 0; j < 3; ++j) { acc[0][j] += w[rr][j] * s0[0]; acc[1][j] += w[rr][j] * s0[1]; acc[2][j] += w[rr][j] * s0[2]; acc[3][j] += w[rr][j] * s0[3]; acc[4][j] += w[rr][j] * s4; } }
        }
#pragma unroll
        for (int v = 0; v < 5; ++v)
#pragma unroll
            for (int j = 0; j < 3; ++j)
#pragma unroll
                for (int c = 0; c < 4; ++c) __hip_atomic_fetch_add(accl + v * 768 + j * 256 + lane * 4 + c, acc[v][j][c], __ATOMIC_RELAXED, __HIP_MEMORY_SCOPE_WORKGROUP);
        __syncthreads();
        float* mod = (float*)(ws + WS_CTL + CTL_MOD) + (size_t)l * 5 * 12288;
        for (int i = wave * 64 + lane; i < 3840; i += NTHR) { const int v = i / 768, c = i - v * 768; float val = accl[i];
            if (rch == 0) val += PIN(I_BADA)[(size_t)l * 12288 + cb * 768 + c];
            atomicAdd(mod + (size_t)v * 12288 + cb * 768 + c, val); }
        __syncthreads();
    }
    if (PROBE_T && blockIdx.x == 0 && wave == 0 && lane == 0) { volatile LAS unsigned* M_ = (volatile LAS unsigned*)(lds + MISC_OFF); asm volatile("s_waitcnt vmcnt(0)" ::: "memory"); const unsigned long long r_ = wall_clock64(); M_[64 + 30] = (unsigned)r_; M_[65 + 30] = (unsigned)(r_ >> 32); }
    if (gw == NGW - 1) {
        float* tab = (float*)(ws + WS_TAB);
        for (int i = lane; i < 1024; i += 64) { const int pos = i >> 4, j = i & 15; const float fr = powf(10000.0f, -(float)j / 16.0f), a = (float)pos * fr; tab[TB_C64 + i] = cosf(a); tab[TB_S64 + i] = sinf(a); }
        for (int i = lane; i < 2048; i += 64) { const int pos = i >> 5, j = i & 31; const float fr = powf(10000.0f, -(float)j / 32.0f), a = (float)pos * fr; tab[TB_C128 + i] = cosf(a); tab[TB_S128 + i] = sinf(a); }
        for (int l = 0; l < 2; ++l) {
            const float d1 = wave_sum(PIN(I_LQ1)[l * 64 + lane] * PIN(I_LK1)[l * 64 + lane]), d2 = wave_sum(PIN(I_LQ2)[l * 64 + lane] * PIN(I_LK2)[l * 64 + lane]);
            const float lam_init = 0.8f - 0.6f * expf(-0.3f * (float)l);
            if (lane == 0) { tab[TB_LAM + 2 * l] = expf(d1) - expf(d2) + lam_init; tab[TB_LAM + 2 * l + 1] = lam_init; }
        }
    }
    LAS unsigned* scr = (LAS unsigned*)(lds + wave * 16384);
    constexpr int IT_IN = 64 * 205, IT_UQ = 12 * 24, IT_UKV = 8 * 32, IT_PAD = 192, IT_L = IT_IN + IT_UQ + IT_UKV + IT_PAD;
    for (int it = gw; it < 2 * IT_L; it += NGW) {
        const int l = it / IT_L; int r = it - l * IT_L;
        if (r < IT_IN) { const int kb = r / 205, nb = r - kb * 205, nn = nb * 64; const int ns = nn < 5376 ? nn : (nn < 13056 ? nn + 64 : nn - 13056 + 5376);
            transpose_item(PIN(I_WIN) + (size_t)l * DM * INC, INC, kb * 64, ns, (bf16_t*)(ws + WS_BT1 + l * BT1_L), DM, nn, scr, lane); continue; }
        r -= IT_IN;
        if (r < IT_UQ) { const int kb = r / 24, nb = r - kb * 24; transpose_item(PIN(I_WUQ) + (size_t)l * 768 * 1536, 1536, kb * 64, nb * 64, (bf16_t*)(ws + WS_BUQ + l * BUQ_L), 768, nb * 64, scr, lane, PIN(I_BQN) + (size_t)l * 768); continue; }
        r -= IT_UQ;
        if (r < IT_UKV) { const int kb = r >> 5, nb = r & 31; transpose_item(PIN(I_WUKV) + (size_t)l * 512 * 2048, 2048, kb * 64, nb * 64, (bf16_t*)(ws + WS_BUKV + l * BUKV_L), 512, nb * 64, scr, lane, PIN(I_BKVN) + (size_t)l * 512); continue; }
        r -= IT_UKV;
        { u32x4* p = (u32x4*)((bf16_t*)(ws + WS_BT1 + l * BT1_L) + (size_t)(INC + r) * DM) + lane;
#pragma unroll
          for (int j = 0; j < 8; ++j) p[64 * j] = (u32x4){0u, 0u, 0u, 0u}; }
    }
}

__device__ __forceinline__ void ph_wout(LAS unsigned char* lds, int l, int wv, int wg0, int nwg) {
    KARGS_P(); PH_IDS();
    if (wg0 < 0) return;
    PH_WS();
    LAS unsigned* scr = (LAS unsigned*)(lds + wave * 16384);
    for (int r = wg0 * NWAVES + wave; r < 64 * 64; r += nwg * NWAVES) { const int kb = r >> 6, nb = r & 63;
        transpose_item(PIN(I_WOUT) + (size_t)l * DM * DM, DM, kb * 64, nb * 64, (bf16_t*)(ws + WS_BT2 + l * BT2_L), DM, nb * 64, scr, lane); }
}

__device__ __forceinline__ void ph_norm(LAS unsigned char* lds, int l, int wv) {
    KARGS_P(); PH_IDS();
    PH_WS();
    const float* mod = (const float*)(ws + WS_CTL + CTL_MOD) + (size_t)l * 5 * 12288;
    const float* g = PIN(I_NORMG) + (size_t)l * DM;
    bf16_t* H = (bf16_t*)(ws + WS_H);
    const int G = gridDim.x, rpb = (NTOK + G - 1) / G, row0 = blockIdx.x * rpb, row1 = row0 + rpb < NTOK ? row0 + rpb : NTOK;
    if (row0 >= row1) return;
    const int vlo = row0 < NP ? 0 : 1 + ((row0 - NP) >> 11), vhi = (row1 - 1) < NP ? 0 : 1 + ((row1 - 1 - NP) >> 11);
    LAS f32x4* AB = (LAS f32x4*)lds;
    for (int i = wave * 64 + lane; i < 2048; i += NTHR) { const int hiv = i >> 10, c = (i & 1023) * 4; const float* mv = mod + (size_t)(hiv ? vhi : vlo) * 12288;
        const f32x4 gg = *(const f32x4*)(g + c), sh = *(const f32x4*)(mv + c), scl = *(const f32x4*)(mv + 4096 + c);
        AB[(hiv * 2) * 1024 + (i & 1023)] = gg * (scl + 1.0f); AB[(hiv * 2 + 1) * 1024 + (i & 1023)] = sh; }
    __syncthreads();
#define NORM_XR(tok_) ((tok_) < NP ? PIN(I_XP) + (size_t)(tok_) * DM : PIN(I_XS) + (size_t)((tok_) - NP) * DM)
    const bf16_t* DL = (const bf16_t*)(ws + WS_OB);
    for (int tok = row0 + wave; tok < row1; tok += NWAVES) {
        f32x4 x[16];
        if (l) { u32x2 d[16];
#pragma unroll
            for (int j = 0; j < 16; ++j) d[j] = *(const u32x2*)(DL + (size_t)tok * DM + (j * 64 + lane) * 4);
            __builtin_amdgcn_sched_barrier(0);
#pragma unroll
            for (int j = 0; j < 16; ++j) x[j] = (f32x4){bflo(d[j].x), bfhi(d[j].x), bflo(d[j].y), bfhi(d[j].y)}; }
        else { const float* xr = NORM_XR(tok);
#pragma unroll
            for (int j = 0; j < 16; ++j) x[j] = *(const f32x4*)(xr + (j * 64 + lane) * 4); }
        __builtin_amdgcn_sched_barrier(0);
        const int v = tok < NP ? 0 : 1 + ((tok - NP) >> 11);
        const LAS f32x4* Av = AB + (v == vlo ? 0 : 2048); const LAS f32x4* Bv = Av + 1024;
        float ss = 0.f;
#pragma unroll
        for (int j = 0; j < 16; ++j) ss += (x[j][0] * x[j][0] + x[j][1] * x[j][1]) + (x[j][2] * x[j][2] + x[j][3] * x[j][3]);
        const float rstd = 1.0f / sqrtf(wave_sum(ss) * (1.0f / DM) + EPS);
        bf16_t* hr = H + (size_t)tok * DM;
#pragma unroll
        for (int j = 0; j < 16; ++j) { const int c4 = j * 64 + lane; const f32x4 y = (x[j] * rstd) * Av[c4] + Bv[c4];
            u32x2 w; w.x = pk2(y[0], y[1]); w.y = pk2(y[2], y[3]); *(u32x2*)(hr + c4 * 4) = w; }
    }
#undef NORM_XR
    __syncthreads();
}

__device__ __forceinline__ void ld16(const bf16_t* p, float (&x)[16]) { const u32x4 a = *(const u32x4*)p, b = *(const u32x4*)(p + 8);
    x[0] = bflo(a.x); x[1] = bfhi(a.x); x[2] = bflo(a.y); x[3] = bfhi(a.y); x[4] = bflo(a.z); x[5] = bfhi(a.z); x[6] = bflo(a.w); x[7] = bfhi(a.w);
    x[8] = bflo(b.x); x[9] = bfhi(b.x); x[10] = bflo(b.y); x[11] = bfhi(b.y); x[12] = bflo(b.z); x[13] = bfhi(b.z); x[14] = bflo(b.w); x[15] = bfhi(b.w); }
__device__ __forceinline__ void st16(bf16_t* p, const float (&x)[16]) { u32x4 a, b; a.x = pk2(x[0], x[1]); a.y = pk2(x[2], x[3]); a.z = pk2(x[4], x[5]); a.w = pk2(x[6], x[7]);
    b.x = pk2(x[8], x[9]); b.y = pk2(x[10], x[11]); b.z = pk2(x[12], x[13]); b.w = pk2(x[14], x[15]); *(u32x4*)p = a; *(u32x4*)(p + 8) = b; }
__device__ __forceinline__ void st16f(float* p, const float (&x)[16]) {
#pragma unroll
    for (int j = 0; j < 4; ++j) *(f32x4*)(p + 4 * j) = (f32x4){x[4 * j], x[4 * j + 1], x[4 * j + 2], x[4 * j + 3]}; }
__device__ __forceinline__ void ld4(const bf16_t* p, float (&x)[4]) { const u32x2 a = *(const u32x2*)p; x[0] = bflo(a.x); x[1] = bfhi(a.x); x[2] = bflo(a.y); x[3] = bfhi(a.y); }
__device__ __forceinline__ void st4(bf16_t* p, const float (&x)[4]) { u32x2 a; a.x = pk2(x[0], x[1]); a.y = pk2(x[2], x[3]); *(u32x2*)p = a; }
__device__ __forceinline__ void cvt16(const float* src, bf16_t* dst) { float x[16];
#pragma unroll
    for (int j = 0; j < 4; ++j) { const f32x4 v = *(const f32x4*)(src + 4 * j); x[4 * j] = v[0]; x[4 * j + 1] = v[1]; x[4 * j + 2] = v[2]; x[4 * j + 3] = v[3]; }
    st16(dst, x); }

__device__ __forceinline__ void up8(const u32x4 w, float (&x)[16], int o) { x[o] = bflo(w.x); x[o + 1] = bfhi(w.x); x[o + 2] = bflo(w.y); x[o + 3] = bfhi(w.y); x[o + 4] = bflo(w.z); x[o + 5] = bfhi(w.z); x[o + 6] = bflo(w.w); x[o + 7] = bfhi(w.w); }
__device__ __forceinline__ u32x4 pk8(const float (&x)[16], int o) { u32x4 w; w.x = pk2(x[o], x[o + 1]); w.y = pk2(x[o + 2], x[o + 3]); w.z = pk2(x[o + 4], x[o + 5]); w.w = pk2(x[o + 6], x[o + 7]); return w; }
template <int MODE> __device__ __forceinline__ void ph_post(int l, int wv, int wg0, int nwg) {
    KARGS_P(); PH_IDS();
    if (wg0 < 0) return;
    PH_WS();
    bf16_t* Z = (bf16_t*)(ws + WS_Z);
    const float* tab = (const float*)(ws + WS_TAB);
    float* out = GLOBAL_PTR(float, P.out);
    const float* rsskv = (const float*)(ws + WS_CTL + CTL_RSS) + (size_t)(l * 2 + 1) * NKV;
    constexpr int NIT = MODE == 0 ? NLB * PAST : NTOK;
    for (int it = wg0 * NWAVES + wave; it < NIT; it += nwg * NWAVES) {
        const int r = MODE == 0 ? NP + (it >> 8) * LKV + LSEQ + (it & 255) : kvrow_of_tok(it);
        int lq = lane; asm volatile("" : "+v"(lq));
        bf16_t* zr = Z + (size_t)r * LDZ;
        bool lat = false; int t = 0, pb = 0, lb = 0, cp = -1;
        if (r < NP) { pb = r >> 8; t = r & 255; }
        else { const int rr = r - NP; lb = rr / LKV; const int s_ = rr - lb * LKV; if (s_ < LSEQ) { lat = true; t = s_; } else cp = s_ - LSEQ; }
        if (cp >= 0) {
            const size_t ci = (size_t)(lb * 2 + l) * PAST + cp;
            f32x4 va[4][4];
            const float* s4[4] = {PIN(I_CAK) + ci * 1024 + lq * 16, PIN(I_CAV) + ci * 1024 + lq * 16, PIN(I_CDK) + ci * 1024 + lq * 16, PIN(I_CDV) + ci * 1024 + lq * 16};
#pragma unroll
            for (int q = 0; q < 4; ++q)
#pragma unroll
                for (int j = 0; j < 4; ++j) va[q][j] = *(const f32x4*)(s4[q] + 4 * j);
            const f32x4 ck = *(const f32x4*)(PIN(I_CCK) + ci * 256 + lq * 4), cv = *(const f32x4*)(PIN(I_CCV) + ci * 256 + lq * 4);
            const f32x4 b0 = *(const f32x4*)(PIN(I_CBCKV) + ci * 512 + lq * 8), b1 = *(const f32x4*)(PIN(I_CBCKV) + ci * 512 + lq * 8 + 4);
            const float kp = PIN(I_CBKPE)[ci * 64 + lq];
            const int dcol[4] = {ZC_AK, ZC_AV, ZC_DK, ZC_DV};
#pragma unroll
            for (int q = 0; q < 4; ++q) { u32x4 w0, w1; w0.x = pk2(va[q][0][0], va[q][0][1]); w0.y = pk2(va[q][0][2], va[q][0][3]); w0.z = pk2(va[q][1][0], va[q][1][1]); w0.w = pk2(va[q][1][2], va[q][1][3]);
                w1.x = pk2(va[q][2][0], va[q][2][1]); w1.y = pk2(va[q][2][2], va[q][2][3]); w1.z = pk2(va[q][3][0], va[q][3][1]); w1.w = pk2(va[q][3][2], va[q][3][3]);
                *(u32x4*)(zr + dcol[q] + lq * 16) = w0; *(u32x4*)(zr + dcol[q] + lq * 16 + 8) = w1; }
            { u32x2 w; w.x = pk2(ck[0], ck[1]); w.y = pk2(ck[2], ck[3]); *(u32x2*)(zr + ZC_CK + lq * 4) = w; w.x = pk2(cv[0], cv[1]); w.y = pk2(cv[2], cv[3]); *(u32x2*)(zr + ZC_CV + lq * 4) = w; }
            { const f32x4 g0 = *(const f32x4*)(PIN(I_BKVN) + (size_t)l * 512 + lq * 8), g1 = *(const f32x4*)(PIN(I_BKVN) + (size_t)l * 512 + lq * 8 + 4);
              u32x4 w; w.x = pk2(b0[0] / g0[0], b0[1] / g0[1]); w.y = pk2(b0[2] / g0[2], b0[3] / g0[3]); w.z = pk2(b1[0] / g1[0], b1[1] / g1[1]); w.w = pk2(b1[2] / g1[2], b1[3] / g1[3]); *(u32x4*)(zr + ZC_BCKV + lq * 8) = w; }
            zr[ZC_BKPE + lq] = (bf16_t)f2bf(kp);
            continue;
        }
        const size_t po = (size_t)(pb * 2 + l) * PSEQ + t;
        const int prow = t >> 6, pcol = t & 63;
        const f32x4 gkv0 = *(const f32x4*)(PIN(I_BKVN) + (size_t)l * 512 + lq * 8), gkv1 = *(const f32x4*)(PIN(I_BKVN) + (size_t)l * 512 + lq * 8 + 4);
        const f32x4 gck = *(const f32x4*)(PIN(I_CKN) + l * 128 + (lq & 31) * 4);
        const u32x4 r_ckv = *(const u32x4*)(zr + ZC_BCKV + lq * 8);
        const unsigned short r_kpe = zr[ZC_BKPE + lq];
        const u32x2 r_ck = *(const u32x2*)(zr + ZC_CK + lq * 4);
        const u32x4 r_dk0 = *(const u32x4*)(zr + ZC_DK + lq * 16), r_dk1 = *(const u32x4*)(zr + ZC_DK + lq * 16 + 8);
        float t_kc = 0.f, t_ks = 0.f; f32x4 t_dc[4] = {}, t_ds[4] = {}, t_cc = {}, t_cs = {};
        const int lh32 = lq & 31, lv = lq & 3;
        if (lat) {
            { const int pos = lq < 32 ? prow : pcol, j = lq & 15; t_kc = tab[TB_C64 + pos * 16 + j]; t_ks = tab[TB_S64 + pos * 16 + j]; }
            { const int pos = (lh32 >> 3) < 2 ? prow : pcol, fb = (lh32 & 7) * 4; t_cc = *(const f32x4*)(tab + TB_C128 + pos * 32 + fb); t_cs = *(const f32x4*)(tab + TB_S128 + pos * 32 + fb); }
            { const int pos = lv < 2 ? prow : pcol;
#pragma unroll
              for (int j = 0; j < 4; ++j) { t_dc[j] = *(const f32x4*)(tab + TB_C64 + pos * 16 + 4 * j); t_ds[j] = *(const f32x4*)(tab + TB_S64 + pos * 16 + 4 * j); } }
        }
        asm volatile("" ::: "memory"); __builtin_amdgcn_sched_barrier(0);
        if (!lat) { const float x[8] = {bflo(r_ckv.x), bfhi(r_ckv.x), bflo(r_ckv.y), bfhi(r_ckv.y), bflo(r_ckv.z), bfhi(r_ckv.z), bflo(r_ckv.w), bfhi(r_ckv.w)};
          const float rstd = 1.0f / sqrtf(rsskv[r] * (1.0f / 512.0f) + EPS);
          float* op = out + O_BCKV + po * 512 + lq * 8; *(f32x4*)op = (f32x4){x[0] * rstd * gkv0[0], x[1] * rstd * gkv0[1], x[2] * rstd * gkv0[2], x[3] * rstd * gkv0[3]};
          *(f32x4*)(op + 4) = (f32x4){x[4] * rstd * gkv1[0], x[5] * rstd * gkv1[1], x[6] * rstd * gkv1[2], x[7] * rstd * gkv1[3]}; }
        { const float x = bf2f(r_kpe);
          if (!lat) out[O_BKPE + po * 64 + lq] = x;
          else { const float xp = shx<16>(x); const float y = (lq & 16) ? x * t_kc + xp * t_ks : x * t_kc - xp * t_ks; zr[ZC_BKPE + lq] = (bf16_t)f2bf(y); } }
        { float x[4] = {bflo(r_ck.x), bfhi(r_ck.x), bflo(r_ck.y), bfhi(r_ck.y)}; float ss = (x[0] * x[0] + x[1] * x[1]) + (x[2] * x[2] + x[3] * x[3]);
          ss += shx<1>(ss); ss += shx<2>(ss); ss += shx<4>(ss); ss += shx<8>(ss); ss += shx<16>(ss);
          const float rstd = 1.0f / sqrtf(ss * (1.0f / 128.0f) + EPS);
#pragma unroll
          for (int e = 0; e < 4; ++e) x[e] = x[e] * rstd * gck[e];
          if (!lat) *(f32x4*)(out + O_CK + po * 256 + lq * 4) = (f32x4){x[0], x[1], x[2], x[3]};
          else { const bool second = (lh32 >> 3) & 1;
#pragma unroll
              for (int e = 0; e < 4; ++e) { const float xp = shx<8>(x[e]); x[e] = second ? x[e] * t_cc[e] + xp * t_cs[e] : x[e] * t_cc[e] - xp * t_cs[e]; } }
          u32x2 w; w.x = pk2(x[0], x[1]); w.y = pk2(x[2], x[3]); *(u32x2*)(zr + ZC_CK + lq * 4) = w; }
        if (lat) {
            const bool second = lv & 1;
#pragma unroll
            for (int w = 1; w < 2; ++w) { float x[16]; up8(r_dk0, x, 0); up8(r_dk1, x, 8);
#pragma unroll
                for (int e = 0; e < 16; ++e) { const float xp = shx<1>(x[e]); const float cs = t_dc[e >> 2][e & 3], sn = t_ds[e >> 2][e & 3]; x[e] = second ? x[e] * cs + xp * sn : x[e] * cs - xp * sn; }
                bf16_t* p = zr + (w == 0 ? ZC_DQ : ZC_DK) + lq * 16; *(u32x4*)p = pk8(x, 0); *(u32x4*)(p + 8) = pk8(x, 8); }
        }
    }
}

__device__ __forceinline__ void ph_final(int wv) {
    KARGS_P(); PH_IDS();
    PH_WS();
    const float* g = PIN(I_FNG);
    const bf16_t* D0 = (const bf16_t*)(ws + WS_OB); const bf16_t* D1 = (const bf16_t*)(ws + WS_X);
    const unsigned lo16 = (unsigned)lane * 16u, lo8 = (unsigned)lane * 8u;
#define FX(xr_, j) (*(const f32x4*)((const char*)(xr_) + (j) * 1024 + lo16))
#define FD(D_, tok_, j) (*(const u32x2*)((const char*)((D_) + (size_t)(tok_) * DM) + (j) * 512 + lo8))
    for (int tok = gw; tok < NTOK; tok += NGW) {
        f32x4 x[16]; u32x2 e[16]; float ss = 0.f;
#pragma unroll
        for (int j = 0; j < 16; ++j) e[j] = FD(D1, tok, j);
        __builtin_amdgcn_sched_barrier(0);
#pragma unroll
        for (int j = 0; j < 16; ++j) { x[j] = (f32x4){bflo(e[j].x), bfhi(e[j].x), bflo(e[j].y), bfhi(e[j].y)};
            ss += (x[j][0] * x[j][0] + x[j][1] * x[j][1]) + (x[j][2] * x[j][2] + x[j][3] * x[j][3]); }
        const float rstd = 1.0f / sqrtf(wave_sum(ss) * (1.0f / DM) + EPS);
        char* orow = (char*)(GLOBAL_PTR(float, P.out) + (size_t)tok * DM);
#pragma unroll
        for (int j = 0; j < 16; ++j) { *(f32x4*)(orow + j * 1024 + lo16) = (x[j] * rstd) * *(const f32x4*)((const char*)g + j * 1024 + lo16); if ((j & 3) == 3) asm volatile("" ::: "memory"); }
    }
#undef FX
#undef FD
}

constexpr int N_PHASES = 14;
__global__ void __launch_bounds__(NTHR, 2) fwd_kernel(Params Pk) {
    extern __shared__ __attribute__((aligned(16))) unsigned char lds_raw[];
    LAS unsigned char* lds = (LAS unsigned char*)lds_raw;
    volatile LAS unsigned* MISC = (volatile LAS unsigned*)(lds + MISC_OFF);
    const int wv = __builtin_amdgcn_readfirstlane((int)threadIdx.x >> 6);
    const int G = gridDim.x;
    (void)Pk;
    unsigned* ctl; { KARGS_P(); ctl = GLOBAL_PTR(unsigned, (unsigned*)(P.ws + WS_CTL)); }
#define LEADER() (wv == 0 && lane_id() == 0)
    if (wv == 0 && lane_id() < 32) MISC[lane_id()] = 0u;
    __syncthreads();
    XcdBarrier bar; bar.bar = ctl + CW_BAR; bar.x = 0; bar.st = nullptr;
    if (MK_MODE == 0) bar = xcd_barrier_post(ctl + CW_BAR, MISC + 8, LEADER());
    int lo, hi; { KARGS_P(); lo = P.ph_lo; hi = P.ph_hi; } (void)lo; (void)hi;
#ifndef PH_MASK
#define PH_MASK 0x3fffu
#endif
#if MK_MODE == 0
#define IN(k) ((PH_MASK >> (k)) & 1u)
#else
#define IN(k) (((PH_MASK >> (k)) & 1u) && lo <= (k) && (k) < hi)
#endif
#define STAMP(i) do { if (PROBE_T && blockIdx.x == 0 && LEADER()) { const unsigned long long r_ = PROBE_TC ? (unsigned long long)clock64() / 10ull : (unsigned long long)wall_clock64(); MISC[64 + 2 * (i)] = (unsigned)r_; MISC[65 + 2 * (i)] = (unsigned)(r_ >> 32); } } while (0)
#define SEAM(k) do { if (IN(k) && IN((k) + 1)) xcd_barrier(bar, LEADER()); STAMP((k) + 1); } while (0)
    STAMP(0);
    if (IN(0)) { ph_prologue(lds, true, wv); if (PROBE_DUP & 256) ph_prologue(lds, false, wv); }
    SEAM(0);
    for (int l = 0; l < DEPTH; ++l) {
        const int pb = 1 + 6 * l;
        if (PROBE_SLEEP && l == 1) { const unsigned long long t0_ = wall_clock64(); while (wall_clock64() - t0_ < (unsigned long long)PROBE_SLEEP * 100ull) __builtin_amdgcn_s_sleep(32); }
        if (IN(pb + 0)) { ph_norm(lds, l, wv); if (PROBE_DUP & 512) ph_norm(lds, l, wv); }
        SEAM(pb + 0);
        if (PROBE_CLK && l == PROBE_CLK_L && LEADER()) { const unsigned long long c_ = clock64(), r_ = wall_clock64(); MISC[20] = (unsigned)c_; MISC[21] = (unsigned)(c_ >> 32); MISC[22] = (unsigned)r_; MISC[23] = (unsigned)(r_ >> 32); }
        for (int rep_ = 0; rep_ < ((PROBE_DUP & 2) ? 2 : 1); ++rep_)
        if (IN(pb + 1)) { PH_KWS();
            pg8::Gemm g{(const bf16_t*)(ws + WS_H), (const bf16_t*)(ws + WS_BT1 + l * BT1_L), NTOK, LDZ, DM, DM, DM}; pg8::StaticOrder S; S.init(NTOK, LDZ, G, (int)blockIdx.x);
            pg8::EpiZ E{(bf16_t*)(ws + WS_Z), GLOBAL_PTR(float, P.out), l, (float*)(ws + WS_CTL + CTL_RSS) + (size_t)l * 2 * NKV};
            pg8::gemm_phase<pg8::EpiZ, pg8::StaticOrder>(lds, g, S, E, wv);
            { const int nwg_ = (NTOK / 256) * (LDZ / 256), rem_ = nwg_ % G;
              if (rem_ == 0) { ph_post<0>(l, wv, (int)blockIdx.x, G); ph_wout(lds, l, wv, (int)blockIdx.x, G); } else { ph_post<0>(l, wv, (int)blockIdx.x - rem_, G - rem_); ph_wout(lds, l, wv, (int)blockIdx.x - rem_, G - rem_); } }
        }
        if (PROBE_CLK && l == PROBE_CLK_L && LEADER()) { const unsigned long long c_ = clock64(), r_ = wall_clock64(); MISC[24] = (unsigned)c_; MISC[25] = (unsigned)(c_ >> 32); MISC[26] = (unsigned)r_; MISC[27] = (unsigned)(r_ >> 32);
            const unsigned long long r0_ = ((unsigned long long)MISC[23] << 32) | MISC[22]; const unsigned d_ = (unsigned)(r_ - r0_); atomicMax(ctl + 12000, d_); atomicMax(ctl + 12064, 0x7fffffffu ^ d_); }
        SEAM(pb + 1);
        for (int rep_ = 0; rep_ < ((PROBE_DUP & 8) ? 2 : 1); ++rep_)
        if (IN(pb + 3)) ph_post<1>(l, wv, (int)blockIdx.x, G);
        if (IN(pb + 3)) { PH_KWS();
            { pg8::Gemm g{(const bf16_t*)(ws + WS_Z) + ZC_BCQ, (const bf16_t*)(ws + WS_BUQ + l * BUQ_L), NKV, 1536, 768, LDZ, 768}; pg8::StaticOrder S; S.init(NKV, 1536, G, (int)blockIdx.x);
              pg8::EpiScale E{(bf16_t*)(ws + WS_QB), LDQB, (const float*)(ws + WS_CTL + CTL_RSS) + (size_t)(l * 2) * NKV, 1.0f / 768.0f, 0};
              pg8::gemm_phase<pg8::EpiScale, pg8::StaticOrder>(lds, g, S, E, wv); }
            { pg8::Gemm g{(const bf16_t*)(ws + WS_Z) + ZC_BCKV, (const bf16_t*)(ws + WS_BUKV + l * BUKV_L), NKV, 2048, 512, LDZ, 512}; pg8::StaticOrder S; S.init(NKV, 2048, G, G - 1 - (int)blockIdx.x);
              pg8::EpiScale E{(bf16_t*)(ws + WS_KVB), LDKVB, (const float*)(ws + WS_CTL + CTL_RSS) + (size_t)(l * 2 + 1) * NKV, 1.0f / 512.0f, 1};
              pg8::gemm_phase<pg8::EpiScale, pg8::StaticOrder>(lds, g, S, E, wv); }
        }
        SEAM(pb + 3);
        if (IN(pb + 4)) { PH_KWS();
            for (int rnd = 0; rnd < ((PROBE_DUP & 32) ? 4 : 2); ++rnd) {
#define ATT_SECT(sect, DQV, KWV, MSK, DPR) do { const int nu_ = attn_nunits(sect, rnd & 1); \
                if (nu_ > 0) { const att::SectCtx C_{sect, rnd & 1, l, nu_, ctl + CW_Q + 64 * ((l * 4 + rnd) * 4 + sect), (bf16_t*)(ws + WS_Z), (bf16_t*)(ws + WS_QB), (bf16_t*)(ws + WS_KVB), (bf16_t*)(ws + WS_Y), PIN(I_RPB), (const float*)(ws + WS_TAB), PIN(I_SUBLN), PIN(I_CQN)}; \
                    att::attn_section<DQV, KWV, MSK, DPR>(C_, (char*)lds_raw, wv); } } while (0)
#ifndef SECT_MASK
#define SECT_MASK 15
#endif
                if (SECT_MASK & 1) ATT_SECT(0, 192, 192, false, false);
                if (SECT_MASK & 2) ATT_SECT(1, 128, 128, false, false);
                if (SECT_MASK & 4) ATT_SECT(2, 64, 128, false, true);
                if ((SECT_MASK & 8) && (rnd & 1) == 0) ATT_SECT(3, 128, 128, true, false);
#undef ATT_SECT
            }
        }
        SEAM(pb + 4);
        for (int rep_ = 0; rep_ < (((PROBE_DUP & 64) && l == 0) ? 3 : 1); ++rep_)
        if (IN(pb + 5)) { PH_KWS();
            pg8::Gemm g{(const bf16_t*)(ws + WS_Y), (const bf16_t*)(ws + WS_BT2 + l * BT2_L), NTOK, DM, DM, DM, DM}; pg8::StaticOrder S; S.init(NTOK, DM, G, (int)blockIdx.x);
            pg8::EpiDelta E{(bf16_t*)(ws + (l == 0 ? WS_OB : WS_X)), (const float*)(ws + WS_CTL + CTL_MOD) + (size_t)l * 5 * 12288 + 8192, PIN(I_XP), PIN(I_XS), l == 0 ? (const bf16_t*)nullptr : (const bf16_t*)(ws + WS_OB)};
            pg8::gemm_phase<pg8::EpiDelta, pg8::StaticOrder>(lds, g, S, E, wv);
        }
        SEAM(pb + 5);
    }
    if (IN(13)) { ph_final(wv); if (PROBE_DUP & 2048) ph_final(wv); }
    STAMP(14);
    if (PROBE_T && blockIdx.x == 0 && LEADER()) {
        const unsigned long long ta = ((unsigned long long)MISC[65 + 2 * PROBE_T] << 32) | MISC[64 + 2 * PROBE_T], tb = ((unsigned long long)MISC[65 + 2 * PROBE_T2] << 32) | MISC[64 + 2 * PROBE_T2];
        const unsigned long long spin = (ta - tb) * PROBE_MUL, t0 = wall_clock64(); while (wall_clock64() - t0 < spin) __builtin_amdgcn_s_sleep(8);
    }
    if (PROBE_CLK && blockIdx.x == 0 && LEADER()) {
        const unsigned long long c0 = ((unsigned long long)MISC[21] << 32) | MISC[20], r0 = ((unsigned long long)MISC[23] << 32) | MISC[22], c1 = ((unsigned long long)MISC[25] << 32) | MISC[24], r1 = ((unsigned long long)MISC[27] << 32) | MISC[26];
        const unsigned long long dr = r1 - r0, dc = c1 - c0;
        const unsigned long long spin = PROBE_CLK == 1 ? (dr ? dc * 100ull * 100ull / dr : 0ull) : PROBE_CLK == 2 ? dr : PROBE_CLK == 3 ? (unsigned long long)__hip_atomic_load(ctl + 12000, __ATOMIC_RELAXED, __HIP_MEMORY_SCOPE_AGENT) : (unsigned long long)(0x7fffffffu ^ __hip_atomic_load(ctl + 12064, __ATOMIC_RELAXED, __HIP_MEMORY_SCOPE_AGENT));
        const unsigned long long t0 = wall_clock64(); while (wall_clock64() - t0 < spin) __builtin_amdgcn_s_sleep(8);
    }
#undef IN
#undef SEAM
}

extern "C" void kernel_launch(void* const* d_in, const int* in_sizes, int n_in, void* d_out, int out_size, void* d_ws, size_t ws_size, hipStream_t stream) {
    static int grid = 0;
    if (grid == 0) {
        if (n_in != 30 || (size_t)out_size != O_END || ws_size < WS_END) { fprintf(stderr, "kernel_launch: shape mismatch: n_in %d out %d ws %zu (need %zu)\n", n_in, out_size, ws_size, (size_t)WS_END); grid = -1; return; }
        int dev = 0, cus = 0, per_cu = 0;
        if (hipGetDevice(&dev) != hipSuccess || hipDeviceGetAttribute(&cus, hipDeviceAttributeMultiprocessorCount, dev) != hipSuccess) { fprintf(stderr, "kernel_launch: device query failed\n"); grid = -1; return; }
        if (hipFuncSetAttribute((const void*)fwd_kernel, hipFuncAttributeMaxDynamicSharedMemorySize, LDS_BYTES) != hipSuccess) { fprintf(stderr, "kernel_launch: hipFuncSetAttribute failed\n"); grid = -1; return; }
        if (hipOccupancyMaxActiveBlocksPerMultiprocessor(&per_cu, (const void*)fwd_kernel, NTHR, LDS_BYTES) != hipSuccess || per_cu < 1)
            fprintf(stderr, "kernel_launch: note: occupancy query reports %d workgroups per CU\n", per_cu);
        (void)hipGetLastError();
        grid = cus;
    }
    if (grid < 0) return;
    if (hipMemsetAsync((char*)d_ws + WS_CTL, 0, CTL_BYTES, stream) != hipSuccess) { fprintf(stderr, "kernel_launch: memset failed\n"); return; }
    Params p{};
    for (int i = 0; i < 30; ++i) p.in[i] = (const float*)d_in[i];
    p.out = (float*)d_out; p.ws = (unsigned char*)d_ws;
#if MK_MODE == 0
    p.ph_lo = 0; p.ph_hi = N_PHASES;
    hipLaunchKernelGGL(fwd_kernel, dim3(grid), dim3(NTHR), LDS_BYTES, stream, p);
#else
    for (int ph = 0; ph < N_PHASES; ++ph) {
        p.ph_lo = ph; p.ph_hi = ph + 1;
        hipLaunchKernelGGL(fwd_kernel, dim3(grid), dim3(NTHR), LDS_BYTES, stream, p);
    }
#endif
    const hipError_t le = hipPeekAtLastError();
    if (le != hipSuccess) fprintf(stderr, "kernel_launch: launch failed: %s\n", hipGetErrorName(le));
}
```
